# Optimizing an MI355X kernel written in HIP

```python
import math
import jax, jax.numpy as jnp
from jax import lax
import numpy as np

D_MODEL = 1024
BATCH = 8
SEQ = 4096
DEPTH = 1

MIX_WIDTH = D_MODEL
DIFF_WIDTH = MIX_WIDTH // 2
RWKV_WIDTH = MIX_WIDTH - DIFF_WIDTH
DIFF_HEAD_DIM = 64
DIFF_HEADS = DIFF_WIDTH // (2 * DIFF_HEAD_DIM)
RWKV_HEAD_SIZE = 64
RWKV_HEADS = RWKV_WIDTH // RWKV_HEAD_SIZE
DECAY_LORA = 64
ICLR_LORA = 64
GATE_LORA = 128
IN_WIDTH = 3 * DIFF_WIDTH + 3 * RWKV_WIDTH
FFN_HIDDEN = ((8 * D_MODEL + 3 * 256 - 1) // (3 * 256)) * 256
Q_BLOCK = 128
RMS_EPS = 1e-6
SUBLN_EPS = 1e-5
LNX_EPS = 1e-5 * RWKV_HEAD_SIZE

kernel_name = "hymba_diffattn_rwkv7_sandwich_adaln"


def rms_norm(x, g, eps=RMS_EPS):
    xf = x.astype(jnp.float32)
    y = xf * lax.rsqrt(jnp.mean(xf * xf, axis=-1, keepdims=True) + eps)
    return (y * g.astype(jnp.float32)).astype(x.dtype)


def token_shift(t):
    return jnp.pad(t, ((0, 0), (1, 0), (0, 0)))[:, :-1]


def diff_attention(q, k, v, lam, lam_init, subln_g):
    B, S = q.shape[0], q.shape[1]
    scale = DIFF_HEAD_DIM ** -0.5
    vf = v.astype(jnp.float32)
    outs = []
    for i in range(S // Q_BLOCK):
        start, end = i * Q_BLOCK, (i + 1) * Q_BLOCK
        qb = q[:, start:end]
        kb = k[:, :end]
        s = jnp.einsum('bqhcd,bkhcd->bhcqk', qb, kb).astype(jnp.float32) * scale
        qpos = start + jnp.arange(Q_BLOCK)
        kpos = jnp.arange(end)
        mask = kpos[None, :] <= qpos[:, None]
        p = jax.nn.softmax(jnp.where(mask, s, -jnp.inf), axis=-1)
        a = p[:, :, 0] - lam * p[:, :, 1]
        outs.append(jnp.einsum('bhqk,bkhe->bqhe', a, vf[:, :end]))
    o = jnp.concatenate(outs, axis=1)
    o = rms_norm(o, subln_g, SUBLN_EPS) * (1.0 - lam_init)
    return o.reshape(B, S, DIFF_WIDTH)


def wkv7_scan(r, w, k, v, a, b):
    B, _, H, N = r.shape

    def step(state, inp):
        r_t, w_t, k_t, v_t, a_t, b_t = inp
        sa = jnp.einsum('bhvk,bhk->bhv', state, a_t)
        state = (state * w_t[:, :, None, :] + sa[..., None] * b_t[:, :, None, :]
                 + v_t[..., None] * k_t[:, :, None, :])
        return state, jnp.einsum('bhvk,bhk->bhv', state, r_t)

    xs = tuple(jnp.moveaxis(t, 1, 0) for t in (r, w, k, v, a, b))
    state0 = jnp.zeros((B, H, N, N), jnp.float32)
    _, y = lax.scan(step, state0, xs)
    return jnp.moveaxis(y, 0, 1)


def rwkv7_mix(h, p_r, p_k, p_v, mu_r, mu_k, mu_v, mu_w, mu_a, mu_g,
              w0, w1, w2, a0, a1, a2, g1, g2, k_k, k_a, r_k, lnx_g, lnx_b):
    B, S, _ = h.shape
    H, N = RWKV_HEADS, RWKV_HEAD_SIZE
    f32 = jnp.float32
    r = p_r + (token_shift(p_r) - p_r) * mu_r
    k = p_k + (token_shift(p_k) - p_k) * mu_k
    v = p_v + (token_shift(p_v) - p_v) * mu_v
    dh = token_shift(h) - h
    xw = h + dh * mu_w
    xa = h + dh * mu_a
    xg = h + dh * mu_g
    w_log = -jax.nn.softplus(-(w0 + jnp.tanh(xw @ w1) @ w2).astype(f32)) - 0.5
    decay = jnp.exp(-jnp.exp(w_log))
    iclr = jax.nn.sigmoid((a0 + (xa @ a1) @ a2).astype(f32))
    g = (jax.nn.sigmoid(xg @ g1) @ g2).astype(f32)
    kf = k.astype(f32)
    kk = (kf * k_k.astype(f32)).reshape(B, S, H, N)
    kk = kk / jnp.maximum(jnp.sqrt(jnp.sum(kk * kk, axis=-1, keepdims=True)), 1e-12)
    kf = kf * (1.0 + (iclr - 1.0) * k_a.astype(f32))
    heads = lambda t: t.reshape(B, S, H, N)
    r_h, k_h, v_h = heads(r.astype(f32)), heads(kf), heads(v.astype(f32))
    a_h = heads(iclr)
    y = wkv7_scan(r_h, heads(decay), k_h, v_h, -kk, kk * a_h)
    mean = jnp.mean(y, axis=-1, keepdims=True)
    var = jnp.mean(jnp.square(y - mean), axis=-1, keepdims=True)
    y = (y - mean) * lax.rsqrt(var + LNX_EPS)
    y = y * lnx_g.astype(f32).reshape(H, N) + lnx_b.astype(f32).reshape(H, N)
    bonus = jnp.sum(r_h * k_h * r_k.astype(f32), axis=-1, keepdims=True) * v_h
    return (y + bonus).reshape(B, S, RWKV_WIDTH) * g


def setup_inputs(seed: int = 0) -> dict:
    key = jax.random.key(seed)
    ks = iter(jax.random.split(key, 48))
    nrm = lambda shape, s: jax.random.normal(next(ks), shape, jnp.float32) * s
    uni = lambda shape, lo, hi: jax.random.uniform(next(ks), shape, jnp.float32, lo, hi)
    L, D = DEPTH, D_MODEL
    gain = lambda n: 1.0 + nrm((L, n), 0.02)
    return {
        "x": nrm((BATCH, SEQ, D), 1.0),
        "c": nrm((BATCH, D), 1.0),
        "w_ada": nrm((L, D, 6 * D), 0.5 * D ** -0.5),
        "b_ada": nrm((L, 6 * D), 0.02),
        "g_pre_mix": gain(D),
        "g_post_mix": gain(D),
        "g_pre_ffn": gain(D),
        "g_post_ffn": gain(D),
        "w_in": nrm((L, D, IN_WIDTH), D ** -0.5),
        "lam_q1": nrm((L, DIFF_HEAD_DIM), 0.1),
        "lam_k1": nrm((L, DIFF_HEAD_DIM), 0.1),
        "lam_q2": nrm((L, DIFF_HEAD_DIM), 0.1),
        "lam_k2": nrm((L, DIFF_HEAD_DIM), 0.1),
        "subln_g": gain(2 * DIFF_HEAD_DIM),
        "mu_r": uni((L, RWKV_WIDTH), 0.0, 1.0),
        "mu_k": uni((L, RWKV_WIDTH), 0.0, 1.0),
        "mu_v": uni((L, RWKV_WIDTH), 0.0, 1.0),
        "mu_w": uni((L, D), 0.0, 1.0),
        "mu_a": uni((L, D), 0.0, 1.0),
        "mu_g": uni((L, D), 0.0, 1.0),
        "w0": uni((L, RWKV_WIDTH), -6.0, 1.0),
        "w1": nrm((L, D, DECAY_LORA), D ** -0.5),
        "w2": nrm((L, DECAY_LORA, RWKV_WIDTH), 0.5 * DECAY_LORA ** -0.5),
        "a0": nrm((L, RWKV_WIDTH), 0.1),
        "a1": nrm((L, D, ICLR_LORA), D ** -0.5),
        "a2": nrm((L, ICLR_LORA, RWKV_WIDTH), 0.5 * ICLR_LORA ** -0.5),
        "g1": nrm((L, D, GATE_LORA), D ** -0.5),
        "g2": nrm((L, GATE_LORA, RWKV_WIDTH), GATE_LORA ** -0.5),
        "k_k": 0.85 + nrm((L, RWKV_WIDTH), 0.02),
        "k_a": 1.0 + nrm((L, RWKV_WIDTH), 0.02),
        "r_k": nrm((L, RWKV_HEADS, RWKV_HEAD_SIZE), 0.1),
        "lnx_g": gain(RWKV_WIDTH),
        "lnx_b": nrm((L, RWKV_WIDTH), 0.02),
        "w_out": nrm((L, MIX_WIDTH, D), MIX_WIDTH ** -0.5),
        "w_gate": nrm((L, D, FFN_HIDDEN), D ** -0.5),
        "w_up": nrm((L, D, FFN_HIDDEN), D ** -0.5),
        "w_down": nrm((L, FFN_HIDDEN, D), FFN_HIDDEN ** -0.5),
    }


def reference(x, c, w_ada, b_ada, g_pre_mix, g_post_mix, g_pre_ffn, g_post_ffn, w_in,
              lam_q1, lam_k1, lam_q2, lam_k2, subln_g, mu_r, mu_k, mu_v, mu_w, mu_a, mu_g,
              w0, w1, w2, a0, a1, a2, g1, g2, k_k, k_a, r_k, lnx_g, lnx_b, w_out,
              w_gate, w_up, w_down):
    B, S, D = x.shape
    split_at = [DIFF_WIDTH, 2 * DIFF_WIDTH, 3 * DIFF_WIDTH,
                3 * DIFF_WIDTH + RWKV_WIDTH, 3 * DIFF_WIDTH + 2 * RWKV_WIDTH]
    for l in range(DEPTH):
        ada = jax.nn.silu(c) @ w_ada[l] + b_ada[l]
        sh_m, sc_m, gt_m, sh_f, sc_f, gt_f = jnp.split(ada, 6, axis=-1)

        h = rms_norm(x, g_pre_mix[l]) * (1.0 + sc_m[:, None]) + sh_m[:, None]
        proj = h @ w_in[l]
        dq, dk, dv, pr, pk, pv = jnp.split(proj, split_at, axis=-1)

        lam_init = 0.8 - 0.6 * math.exp(-0.3 * l)
        lam = (jnp.exp(jnp.sum(lam_q1[l].astype(jnp.float32) * lam_k1[l].astype(jnp.float32)))
               - jnp.exp(jnp.sum(lam_q2[l].astype(jnp.float32) * lam_k2[l].astype(jnp.float32)))
               + lam_init)
        y_diff = diff_attention(
            dq.reshape(B, S, DIFF_HEADS, 2, DIFF_HEAD_DIM),
            dk.reshape(B, S, DIFF_HEADS, 2, DIFF_HEAD_DIM),
            dv.reshape(B, S, DIFF_HEADS, 2 * DIFF_HEAD_DIM),
            lam, lam_init, subln_g[l])

        y_rwkv = rwkv7_mix(h, pr, pk, pv, mu_r[l], mu_k[l], mu_v[l], mu_w[l], mu_a[l], mu_g[l],
                           w0[l], w1[l], w2[l], a0[l], a1[l], a2[l], g1[l], g2[l],
                           k_k[l], k_a[l], r_k[l], lnx_g[l], lnx_b[l])

        y_mix = jnp.concatenate([y_diff, y_rwkv], axis=-1).astype(x.dtype) @ w_out[l]
        x = x + gt_m[:, None] * rms_norm(y_mix, g_post_mix[l])

        h = rms_norm(x, g_pre_ffn[l]) * (1.0 + sc_f[:, None]) + sh_f[:, None]
        f = (jax.nn.silu(h @ w_gate[l]) * (h @ w_up[l])) @ w_down[l]
        x = x + gt_f[:, None] * rms_norm(f, g_post_ffn[l])
    return x
```

```cpp
#include <hip/hip_runtime.h>
#include <hip/hip_cooperative_groups.h>
#include <cstdio>
#include <cstdint>
namespace cg = cooperative_groups;

#ifndef PROBE_P4FLAGS
#define PROBE_P4FLAGS 0
#endif
#ifndef N_LAUNCH_MODE
#define N_LAUNCH_MODE 1
#endif

#define LAS __attribute__((address_space(3)))
typedef unsigned short bf16_t;
typedef short bf16x8 __attribute__((ext_vector_type(8)));
typedef short s16x4 __attribute__((ext_vector_type(4)));
typedef float f32x2 __attribute__((ext_vector_type(2)));
typedef float f32x4 __attribute__((ext_vector_type(4)));
typedef float f32x16 __attribute__((ext_vector_type(16)));
typedef unsigned u32x2 __attribute__((ext_vector_type(2)));
typedef unsigned u32x4 __attribute__((ext_vector_type(4)));
typedef __bf16 bf16x2_t __attribute__((ext_vector_type(2)));

constexpr int NB = 8, SEQ = 4096, DM = 1024, TOK = NB * SEQ;
constexpr int NPROJ = 3584;
constexpr int FFH = 2816;
constexpr int NTHREADS = 512, NWAVES = 8;
constexpr int LDS_BYTES = 147456;
constexpr float C2 = 0.125f * 1.4426950408889634f;
constexpr float RMS_EPS = 1e-6f, SUBLN_EPS = 1e-5f, LNX_EPS = 64e-5f;

constexpr size_t MiB = 1u << 20;
constexpr size_t WS_CTL = 0, CTL_ZERO_BYTES = 64 * 1024;
constexpr size_t WS_WEXT = 1 * MiB;
constexpr size_t WS_WOUT = 8 * MiB;
constexpr size_t WS_WGU = 10 * MiB;
constexpr size_t WS_WDN = 21 * MiB;
constexpr size_t WS_W2T = 27 * MiB;
constexpr size_t WS_A2T = WS_W2T + 65536;
constexpr size_t WS_G2T = WS_A2T + 65536;
constexpr size_t WS_ADAP = 28 * MiB;
constexpr size_t WS_SSQ1 = 31 * MiB - 0;
constexpr size_t WS_BONUS = 33 * MiB;
constexpr size_t WS_SSQ2 = 34 * MiB;
constexpr size_t WS_PROJ = 36 * MiB;
constexpr size_t WS_H2 = WS_PROJ;
constexpr size_t WS_F = WS_PROJ + 64 * MiB;
constexpr size_t WS_SCAN = 260 * MiB;
constexpr size_t WS_YMIX = WS_SCAN;
constexpr size_t WS_HID = WS_SCAN + 64 * MiB;
constexpr size_t WS_END = 500 * MiB;
constexpr size_t WS_OPS = WS_SCAN;
constexpr int OPS_STRIDE = 14336;
constexpr int OP_RP = 0, OP_WT = 2048, OP_ZT = 4096, OP_ARBT = 4608, OP_ARKT = 5120, OP_BH = 5632, OP_KH = 7680, OP_V = 9728, OP_G = 11776, OP_GC = 13824, OP_BON = 14080;

constexpr int CW_QUEUE = 0;
constexpr int CW_BAR = 4096;

__device__ __forceinline__ unsigned pk2(float lo, float hi) { f32x2 v = {lo, hi}; bf16x2_t b = __builtin_convertvector(v, bf16x2_t); return __builtin_bit_cast(unsigned, b); }
__device__ __forceinline__ float bf2f(unsigned short h) { return __uint_as_float(((unsigned)h) << 16); }
__device__ __forceinline__ float bflo(unsigned w) { return __uint_as_float(w << 16); }
__device__ __forceinline__ float bfhi(unsigned w) { return __uint_as_float(w & 0xffff0000u); }
#define LDS_WAIT() asm volatile("s_waitcnt lgkmcnt(0)" ::: "memory")

namespace pg8 {
constexpr int BM = 256, BK = 64, HALF = 128, HTB = HALF * BK * 2, STAGE_BYTES = 8 * HTB, NXCD = 8, WGM = 8;
__host__ __device__ __forceinline__ int lds_byte(int r, int c) { const int st = (r >> 4) * 2 + (c >> 5), rr = r & 15, cc = c & 31, ob = rr * 64 + cc * 2; return st * 1024 + (ob ^ (((ob >> 9) & 1) << 5)); }
__host__ __device__ __forceinline__ void stage_rc(int b, int& R, int& C) { const int st = b / 1024, sb = b % 1024, swz = sb ^ (((sb >> 9) & 1) << 5); R = (st >> 1) * 16 + swz / 64; C = (st & 1) * 32 + (swz % 64) / 2; }
__host__ __device__ __forceinline__ int perm32(int rho) { const int n = rho >> 4, i = rho & 15; return 8 * (i >> 2) + 4 * n + (i & 3); }
struct Unit { int pm, pn; };
struct Gemm { const bf16_t* A; const bf16_t* Bt; int M, N, K; };
struct StaticOrder {
    int nM, nN, nwg, G, c;
    __host__ __device__ void init(int M, int N, int G_, int c_) { nM = M / BM; nN = N / BM; nwg = nM * nN; G = G_; c = c_; }
    __host__ __device__ bool next(int i, Unit& u) const {
        const long L = (long)i * G + c; if (L >= nwg) return false;
        int wgid = (int)L; { const int q = nwg / NXCD, r = nwg % NXCD, xcd = wgid % NXCD, off = wgid / NXCD; wgid = (xcd < r ? xcd * (q + 1) : r * (q + 1) + (xcd - r) * q) + off; }
        const int nig = WGM * nN, gid = wgid / nig, fm = gid * WGM, gsz = (nM - fm) < WGM ? (nM - fm) : WGM;
        u.pm = fm + ((wgid % nig) % gsz); u.pn = (wgid % nig) / gsz; return true;
    }
    __device__ __forceinline__ void a_ready(const Unit&) const {}
    __device__ __forceinline__ void done(const Unit&) const {}
};
struct EpiBf16 {
    static constexpr bool PERM = true, AFTER_DRAIN = false;
    bf16_t* O; int ldc; int scale_tiles; float scale0;
    __device__ __forceinline__ void operator()(const f32x4 (&acc)[2][2][4][2], const Unit& u, int wr, int wc, int fr, int fq) const {
        const int row0 = u.pm * BM + wr * 64 + fr; const int col0 = u.pn * BM + wc * 32 + 8 * fq;
        const float sc = (u.pn < scale_tiles) ? scale0 : 1.f;
#pragma unroll
        for (int ai = 0; ai < 2; ++ai)
#pragma unroll
            for (int m = 0; m < 4; ++m) { bf16_t* rowp = O + (size_t)(row0 + ai * HALF + m * 16) * ldc + col0;
#pragma unroll
                for (int bj = 0; bj < 2; ++bj) { const f32x4 v0 = acc[ai][bj][m][0] * sc, v1 = acc[ai][bj][m][1] * sc;
                    u32x4 w; w.x = pk2(v0[0], v0[1]); w.y = pk2(v0[2], v0[3]); w.z = pk2(v1[0], v1[1]); w.w = pk2(v1[2], v1[3]);
                    *(u32x4*)(rowp + bj * HALF) = w; } }
    }
};
struct EpiBf16Ssq {
    static constexpr bool PERM = true, AFTER_DRAIN = false;
    bf16_t* O; int ldc; float* ssq;
    __device__ __forceinline__ void operator()(const f32x4 (&acc)[2][2][4][2], const Unit& u, int wr, int wc, int fr, int fq) const {
        const int row0 = u.pm * BM + wr * 64 + fr; const int col0 = u.pn * BM + wc * 32 + 8 * fq;
#pragma unroll
        for (int ai = 0; ai < 2; ++ai)
#pragma unroll
            for (int m = 0; m < 4; ++m) { const int row = row0 + ai * HALF + m * 16; bf16_t* rowp = O + (size_t)row * ldc + col0; float s = 0.f;
#pragma unroll
                for (int bj = 0; bj < 2; ++bj) { const f32x4 v0 = acc[ai][bj][m][0], v1 = acc[ai][bj][m][1];
                    s += (v0[0] * v0[0] + v0[1] * v0[1]) + (v0[2] * v0[2] + v0[3] * v0[3]) + (v1[0] * v1[0] + v1[1] * v1[1]) + (v1[2] * v1[2] + v1[3] * v1[3]);
                    u32x4 w; w.x = pk2(v0[0], v0[1]); w.y = pk2(v0[2], v0[3]); w.z = pk2(v1[0], v1[1]); w.w = pk2(v1[2], v1[3]);
                    *(u32x4*)(rowp + bj * HALF) = w; }
                s += __shfl_xor(s, 16); s += __shfl_xor(s, 32);
                if (fq == 0) ssq[(size_t)row * 16 + u.pn * 4 + wc] = s; }
    }
};
struct EpiSwiGlu {
    static constexpr bool PERM = true, AFTER_DRAIN = false;
    bf16_t* O; int ldc;
    __device__ __forceinline__ void operator()(const f32x4 (&acc)[2][2][4][2], const Unit& u, int wr, int wc, int fr, int fq) const {
        const int row0 = u.pm * BM + wr * 64 + fr; const int col0 = u.pn * HALF + wc * 32 + 8 * fq;
#pragma unroll
        for (int ai = 0; ai < 2; ++ai)
#pragma unroll
            for (int m = 0; m < 4; ++m) { bf16_t* rowp = O + (size_t)(row0 + ai * HALF + m * 16) * ldc + col0; float h[8];
#pragma unroll
                for (int n = 0; n < 2; ++n)
#pragma unroll
                    for (int e = 0; e < 4; ++e) { const float g = acc[ai][0][m][n][e], up = acc[ai][1][m][n][e];
                        const float sg = g * __builtin_amdgcn_rcpf(1.f + __builtin_amdgcn_exp2f(-1.4426950408889634f * g)); h[n * 4 + e] = sg * up; }
                u32x4 w; w.x = pk2(h[0], h[1]); w.y = pk2(h[2], h[3]); w.z = pk2(h[4], h[5]); w.w = pk2(h[6], h[7]);
                *(u32x4*)rowp = w; }
    }
};

template <class Epi, class Sched, bool ALIGN_EPI = false, bool SP2 = false>
__device__ __forceinline__ void gemm_phase(LAS unsigned char* lds, const Gemm g, const Sched& S, const Epi& E) {
    const int tid = threadIdx.x, wid = __builtin_amdgcn_readfirstlane(tid >> 6), lane = tid & 63, wr = wid >> 2, wc = wid & 3, fr = lane & 15, fq = lane >> 4;
    const int K = g.K, nt = K / BK;
    unsigned voffA[2], voffB[2];
#pragma unroll
    for (int i = 0; i < 2; ++i) { int R, C; stage_rc(tid * 16 + i * 8192, R, C); const int Rb = Epi::PERM ? ((R & ~31) + perm32(R & 31)) : R;
        voffA[i] = (unsigned)(R * K + C) * 2u; voffB[i] = (unsigned)(Rb * K + C) * 2u; }
    const size_t kstep = (size_t)(BK * 2);
    const size_t hstep = (size_t)HALF * K * 2;
    const size_t tstep = 2 * hstep;
    const unsigned ldsw = (unsigned)wid * 1024u;
    const int aoff = lds_byte(wr * 64 + fr, fq * 8), boff = lds_byte(wc * 32 + fr, fq * 8);
#define PG8_SA(b, h) (((b) * 2 + (h)) * HTB)
#define PG8_SB(b, h) ((4 + (b) * 2 + (h)) * HTB)
#define PG8_STAGE(bufoff, gbase, voff) do { _Pragma("unroll") for (int _i = 0; _i < 2; ++_i) \
        __builtin_amdgcn_global_load_lds((const unsigned*)((const char*)(gbase) + (voff)[_i]), (LAS unsigned*)(lds + (bufoff) + ldsw + _i * 8192), 16, 0, 0); } while (0)
#define PG8_LDA(dst, b, h) do { _Pragma("unroll") for (int m = 0; m < 4; ++m) _Pragma("unroll") for (int k = 0; k < 2; ++k) dst[m][k] = *(const LAS bf16x8*)(lds + PG8_SA(b, h) + aoff + m * 2048 + k * 1024); } while (0)
#define PG8_LDB(dst, b, h) do { _Pragma("unroll") for (int n = 0; n < 2; ++n) _Pragma("unroll") for (int k = 0; k < 2; ++k) dst[n][k] = *(const LAS bf16x8*)(lds + PG8_SB(b, h) + boff + n * 2048 + k * 1024); } while (0)
#define PG8_MMA(ai, bj, At, Bt) do { __builtin_amdgcn_s_setprio(1); _Pragma("unroll") for (int m = 0; m < 4; ++m) _Pragma("unroll") for (int n = 0; n < 2; ++n) _Pragma("unroll") for (int k = 0; k < 2; ++k) \
        acc[ai][bj][m][n] = __builtin_amdgcn_mfma_f32_16x16x32_bf16(Bt[n][k], At[m][k], acc[ai][bj][m][n], 0, 0, 0); __builtin_amdgcn_s_setprio(0); } while (0)
#define PG8_WAIT_V(n) asm volatile("s_waitcnt vmcnt(" #n ")" ::: "memory")
#define PG8_WAIT_L(n) asm volatile("s_waitcnt lgkmcnt(" #n ")" ::: "memory")
#define PG8_BAR __builtin_amdgcn_s_barrier()
#define PG8_SCHED __builtin_amdgcn_sched_barrier(0)
    Unit cur, nxt; int ui = 0;
    if (!S.next(0, cur)) return;
    f32x4 acc[2][2][4][2];
#pragma unroll
    for (int a = 0; a < 2; ++a)
#pragma unroll
        for (int b = 0; b < 2; ++b)
#pragma unroll
            for (int m = 0; m < 4; ++m)
#pragma unroll
                for (int n = 0; n < 2; ++n) acc[a][b][m][n] = (f32x4){0.f, 0.f, 0.f, 0.f};
    bf16x8 At[4][2], B0[2][2], B1[2][2];
    const char* cA = (const char*)g.A + (size_t)cur.pm * tstep; const char* cB = (const char*)g.Bt + (size_t)cur.pn * tstep;
    S.a_ready(cur);
    if constexpr (SP2) {
        PG8_STAGE(PG8_SB(0, 0), cB, voffB); PG8_STAGE(PG8_SB(0, 1), cB + hstep, voffB); PG8_STAGE(PG8_SA(0, 0), cA, voffA); PG8_STAGE(PG8_SA(0, 1), cA + hstep, voffA);
        if (wr == 1) PG8_BAR;
        PG8_WAIT_V(2); PG8_BAR;
        PG8_STAGE(PG8_SB(1, 0), cB + kstep, voffB); PG8_STAGE(PG8_SA(1, 0), cA + kstep, voffA); PG8_STAGE(PG8_SB(1, 1), cB + hstep + kstep, voffB);
        PG8_WAIT_V(6); PG8_BAR;
    } else {
        PG8_STAGE(PG8_SB(0, 0), cB, voffB); PG8_STAGE(PG8_SA(0, 0), cA, voffA); PG8_STAGE(PG8_SB(0, 1), cB + hstep, voffB); PG8_STAGE(PG8_SA(0, 1), cA + hstep, voffA);
        if (wr == 1) PG8_BAR;
        PG8_WAIT_V(4); PG8_BAR;
        PG8_STAGE(PG8_SB(1, 0), cB + kstep, voffB); PG8_STAGE(PG8_SA(1, 0), cA + kstep, voffA); PG8_STAGE(PG8_SB(1, 1), cB + hstep + kstep, voffB);
        PG8_WAIT_V(6); PG8_BAR;
    }
    for (;;) {
        const bool has_next = S.next(ui + 1, nxt);
        const char* nA = has_next ? (const char*)g.A + (size_t)nxt.pm * tstep : cA; const char* nB = has_next ? (const char*)g.Bt + (size_t)nxt.pn * tstep : cB;
        for (int t = 0; t < nt; t += 2) {
            const bool last = (t == nt - 2);
            const char* a1 = cA + (size_t)(t + 1) * kstep;
            const char* a2 = last ? nA : cA + (size_t)(t + 2) * kstep; const char* b2 = last ? nB : cB + (size_t)(t + 2) * kstep;
            const char* a3 = a2 + kstep; const char* b3 = b2 + kstep;
            if (last && has_next) S.a_ready(nxt);
            if constexpr (SP2) {
            PG8_LDB(B0, 0, 0); PG8_LDB(B1, 0, 1); PG8_SCHED; PG8_LDA(At, 0, 0); PG8_STAGE(PG8_SA(1, 1), a1 + hstep, voffA);
            PG8_WAIT_V(8); PG8_WAIT_L(0); PG8_BAR; PG8_MMA(0, 0, At, B0); PG8_MMA(0, 1, At, B1); PG8_BAR; PG8_SCHED;
            PG8_LDA(At, 0, 1); PG8_STAGE(PG8_SB(0, 0), b2, voffB); PG8_STAGE(PG8_SB(0, 1), b2 + hstep, voffB); PG8_STAGE(PG8_SA(0, 0), a2, voffA);
            PG8_WAIT_V(8); PG8_WAIT_L(0); PG8_BAR; PG8_MMA(1, 0, At, B0); PG8_MMA(1, 1, At, B1); PG8_BAR; PG8_SCHED;
            PG8_LDB(B0, 1, 0); PG8_LDB(B1, 1, 1); PG8_SCHED; PG8_LDA(At, 1, 0); PG8_STAGE(PG8_SA(0, 1), a2 + hstep, voffA);
            PG8_WAIT_V(8); PG8_WAIT_L(0); PG8_BAR; PG8_MMA(0, 0, At, B0); PG8_MMA(0, 1, At, B1); PG8_BAR; PG8_SCHED;
            PG8_LDA(At, 1, 1); PG8_STAGE(PG8_SB(1, 0), b3, voffB); PG8_STAGE(PG8_SB(1, 1), b3 + hstep, voffB); PG8_STAGE(PG8_SA(1, 0), a3, voffA);
            PG8_WAIT_V(8); PG8_WAIT_L(0); PG8_BAR; PG8_MMA(1, 0, At, B0); PG8_MMA(1, 1, At, B1); PG8_BAR; PG8_SCHED;
            } else {
            PG8_LDB(B0, 0, 0); PG8_SCHED; PG8_LDA(At, 0, 0); PG8_STAGE(PG8_SA(1, 1), a1 + hstep, voffA);
            PG8_WAIT_L(8); PG8_BAR; PG8_WAIT_L(0); PG8_MMA(0, 0, At, B0); PG8_BAR; PG8_SCHED;
            PG8_LDB(B1, 0, 1); PG8_STAGE(PG8_SB(0, 0), b2, voffB);
            PG8_BAR; PG8_WAIT_L(0); PG8_MMA(0, 1, At, B1); PG8_BAR;
            PG8_LDA(At, 0, 1); PG8_STAGE(PG8_SA(0, 0), a2, voffA);
            PG8_BAR; PG8_WAIT_L(0); PG8_MMA(1, 0, At, B0); PG8_BAR; PG8_SCHED;
            PG8_STAGE(PG8_SB(0, 1), b2 + hstep, voffB);
            PG8_WAIT_V(6); PG8_BAR; PG8_MMA(1, 1, At, B1); PG8_BAR;
            PG8_LDB(B0, 1, 0); PG8_SCHED; PG8_LDA(At, 1, 0); PG8_STAGE(PG8_SA(0, 1), a2 + hstep, voffA);
            PG8_WAIT_L(8); PG8_BAR; PG8_WAIT_L(0); PG8_MMA(0, 0, At, B0); PG8_BAR; PG8_SCHED;
            PG8_LDB(B1, 1, 1); PG8_STAGE(PG8_SB(1, 0), b3, voffB);
            PG8_BAR; PG8_WAIT_L(0); PG8_MMA(0, 1, At, B1); PG8_BAR;
            PG8_LDA(At, 1, 1); PG8_STAGE(PG8_SA(1, 0), a3, voffA);
            PG8_BAR; PG8_WAIT_L(0); PG8_MMA(1, 0, At, B0); PG8_BAR; PG8_SCHED;
            PG8_STAGE(PG8_SB(1, 1), b3 + hstep, voffB);
            PG8_WAIT_V(6); PG8_BAR; PG8_MMA(1, 1, At, B1); PG8_BAR;
            }
        }
        if constexpr (ALIGN_EPI) { if (wr == 0) PG8_BAR; }
        if constexpr (!Epi::AFTER_DRAIN) { E(acc, cur, wr, wc, fr, fq); S.done(cur); }
        if (!has_next) break;
#pragma unroll
        for (int a = 0; a < 2; ++a)
#pragma unroll
            for (int b = 0; b < 2; ++b)
#pragma unroll
                for (int m = 0; m < 4; ++m)
#pragma unroll
                    for (int n = 0; n < 2; ++n) acc[a][b][m][n] = (f32x4){0.f, 0.f, 0.f, 0.f};
        cur = nxt; cA = nA; cB = nB; ++ui;
        if constexpr (ALIGN_EPI) { if (wr == 1) PG8_BAR; }
    }
    PG8_WAIT_V(0);
    if constexpr (!ALIGN_EPI) { if (wr == 0) PG8_BAR; }
    PG8_BAR;
#undef PG8_SA
#undef PG8_SB
#undef PG8_STAGE
#undef PG8_LDA
#undef PG8_LDB
#undef PG8_MMA
#undef PG8_WAIT_V
#undef PG8_WAIT_L
#undef PG8_BAR
#undef PG8_SCHED
}
}

struct Args {
    const float* in[37];
    float* out;
    unsigned char* ws;
    int ph_lo, ph_hi, flags, pad;
};
enum { I_X = 0, I_C, I_WADA, I_BADA, I_GPREMIX, I_GPOSTMIX, I_GPREFFN, I_GPOSTFFN, I_WIN, I_LQ1, I_LK1, I_LQ2, I_LK2, I_SUBLN, I_MUR, I_MUK, I_MUV, I_MUW, I_MUA, I_MUG,
       I_W0, I_W1, I_W2, I_A0, I_A1, I_A2, I_G1, I_G2, I_KK, I_KA, I_RK, I_LNXG, I_LNXB, I_WOUT, I_WGATE, I_WUP, I_WDOWN };

__device__ __forceinline__ float wave_sum(float v) {
#pragma unroll
    for (int o = 1; o < 64; o <<= 1) v += __shfl_xor(v, o);
    return v;
}
template <int CTRL> __device__ __forceinline__ float dppf(float x) { return __builtin_bit_cast(float, __builtin_amdgcn_update_dpp(0, __builtin_bit_cast(int, x), CTRL, 0xf, 0xf, true)); }
__device__ __forceinline__ float sum8(float v) { v += dppf<0xB1>(v); v += dppf<0x4E>(v); v += dppf<0x141>(v); return v; }
__device__ __forceinline__ float sum16(float v) { v = sum8(v); v += dppf<0x140>(v); return v; }

__device__ __forceinline__ void tr_item(const float* W, int K, int N, bf16_t* WT, int ldo, int dst_row0, LAS float* scr, int kb, int nb, int lane, const float* mu, int mode) {
    const int k0 = 64 * kb, n0 = 32 * nb;
#pragma unroll 8
    for (int i = 0; i < 32; ++i) { const int kk = 2 * i + (lane >> 5); float v = W[(size_t)(k0 + kk) * N + n0 + (lane & 31)];
        if (mode == 1) v *= (1.f - mu[k0 + kk]); else if (mode == 2) v *= mu[k0 + kk];
        scr[kk * 33 + (lane & 31)] = v; }
    LDS_WAIT(); asm volatile("" ::: "memory");
    const int c = lane & 7;
#pragma unroll
    for (int j = 0; j < 4; ++j) { const int n = (lane >> 3) + 8 * j; const LAS float* s = scr + (8 * c) * 33 + n;
        u32x4 o; o.x = pk2(s[0 * 33], s[1 * 33]); o.y = pk2(s[2 * 33], s[3 * 33]); o.z = pk2(s[4 * 33], s[5 * 33]); o.w = pk2(s[6 * 33], s[7 * 33]);
        *(u32x4*)(WT + (size_t)(dst_row0 + n) * ldo + k0 + 8 * c) = o; }
    LDS_WAIT(); asm volatile("" ::: "memory");
}

__device__ __forceinline__ void phase0_weights(const Args& a, LAS float* scr, int gw, int NGW, int lane) {
    unsigned char* ws = a.ws;
    bf16_t* Wext = (bf16_t*)(ws + WS_WEXT); bf16_t* Wout = (bf16_t*)(ws + WS_WOUT); bf16_t* Wgu = (bf16_t*)(ws + WS_WGU); bf16_t* Wdn = (bf16_t*)(ws + WS_WDN);
    bf16_t* W2t = (bf16_t*)(ws + WS_W2T); bf16_t* A2t = (bf16_t*)(ws + WS_A2T); bf16_t* G2t = (bf16_t*)(ws + WS_G2T);
    constexpr int J0 = 1536, J1 = 32, J5 = 64, J7 = 512, J8 = 1408, J11 = 16, J13 = 32;
    constexpr int NITEMS = J0 + 4 * J1 + 2 * J5 + J7 + 3 * J8 + 2 * J11 + J13;
    for (int it = gw; it < NITEMS; it += NGW) {
        int r = it;
        if (r < J0) { tr_item(a.in[I_WIN], 1024, 3072, Wext, 1024, (r % 96) * 32, scr, r / 96, r % 96, lane, nullptr, 0); continue; } r -= J0;
        if (r < J1) { tr_item(a.in[I_W1], 1024, 64, Wext, 1024, 3072 + (r % 2) * 32, scr, r / 2, r % 2, lane, a.in[I_MUW], 1); continue; } r -= J1;
        if (r < J1) { tr_item(a.in[I_W1], 1024, 64, Wext, 1024, 3136 + (r % 2) * 32, scr, r / 2, r % 2, lane, a.in[I_MUW], 2); continue; } r -= J1;
        if (r < J1) { tr_item(a.in[I_A1], 1024, 64, Wext, 1024, 3200 + (r % 2) * 32, scr, r / 2, r % 2, lane, a.in[I_MUA], 1); continue; } r -= J1;
        if (r < J1) { tr_item(a.in[I_A1], 1024, 64, Wext, 1024, 3264 + (r % 2) * 32, scr, r / 2, r % 2, lane, a.in[I_MUA], 2); continue; } r -= J1;
        if (r < J5) { tr_item(a.in[I_G1], 1024, 128, Wext, 1024, 3328 + (r % 4) * 32, scr, r / 4, r % 4, lane, a.in[I_MUG], 1); continue; } r -= J5;
        if (r < J5) { tr_item(a.in[I_G1], 1024, 128, Wext, 1024, 3456 + (r % 4) * 32, scr, r / 4, r % 4, lane, a.in[I_MUG], 2); continue; } r -= J5;
        if (r < J7) { tr_item(a.in[I_WOUT], 1024, 1024, Wout, 1024, (r % 32) * 32, scr, r / 32, r % 32, lane, nullptr, 0); continue; } r -= J7;
        if (r < J8) { const int nb = r % 88, n0 = nb * 32; tr_item(a.in[I_WGATE], 1024, 2816, Wgu, 1024, 256 * (n0 / 128) + (n0 % 128), scr, r / 88, nb, lane, nullptr, 0); continue; } r -= J8;
        if (r < J8) { const int nb = r % 88, n0 = nb * 32; tr_item(a.in[I_WUP], 1024, 2816, Wgu, 1024, 256 * (n0 / 128) + (n0 % 128) + 128, scr, r / 88, nb, lane, nullptr, 0); continue; } r -= J8;
        if (r < J8) { tr_item(a.in[I_WDOWN], 2816, 1024, Wdn, 2816, (r % 32) * 32, scr, r / 32, r % 32, lane, nullptr, 0); continue; } r -= J8;
        if (r < J11) { tr_item(a.in[I_W2], 64, 512, W2t, 64, r * 32, scr, 0, r, lane, nullptr, 0); continue; } r -= J11;
        if (r < J11) { tr_item(a.in[I_A2], 64, 512, A2t, 64, r * 32, scr, 0, r, lane, nullptr, 0); continue; } r -= J11;
        tr_item(a.in[I_G2], 128, 512, G2t, 128, (r % 16) * 32, scr, r / 16, r % 16, lane, nullptr, 0);
    }
}
__device__ __forceinline__ void phase0(const Args& a, LAS unsigned char* lds) {
    const int tid = threadIdx.x; const int G = gridDim.x; unsigned char* ws = a.ws;
    LAS float* sc = (LAS float*)(lds + 73728);
    const float* cin = a.in[I_C];
    for (int i = tid; i < 8192; i += NTHREADS) { const float v = cin[i]; sc[i] = v * __builtin_amdgcn_rcpf(1.f + __expf(-v)); }
    __syncthreads();
    float* adap = (float*)(ws + WS_ADAP); const float* wada = a.in[I_WADA];
    for (int it = blockIdx.x * NTHREADS + tid; it < 16 * 6144; it += G * NTHREADS) {
        const int col = it % 6144, kc = it / 6144; float acc[8];
#pragma unroll
        for (int b = 0; b < 8; ++b) acc[b] = 0.f;
        for (int k = kc * 64; k < kc * 64 + 64; ++k) { const float w = wada[(size_t)k * 6144 + col];
#pragma unroll
            for (int b = 0; b < 8; ++b) acc[b] += sc[b * 1024 + k] * w; }
#pragma unroll
        for (int b = 0; b < 8; ++b) adap[(size_t)(kc * 8 + b) * 6144 + col] = acc[b];
    }
    __syncthreads();
}
__device__ __forceinline__ float ada_val(const Args& a, int b, int j) {
    const float* adap = (const float*)(a.ws + WS_ADAP); float s = a.in[I_BADA][j];
#pragma unroll
    for (int kc = 0; kc < 16; ++kc) s += adap[(size_t)(kc * 8 + b) * 6144 + j];
    return s;
}

__device__ __forceinline__ void phase1(const Args& a, LAS unsigned char* lds) {
    const int tid = threadIdx.x, lane = tid & 63, wid = __builtin_amdgcn_readfirstlane(tid >> 6);
    LAS float* cA = (LAS float*)lds; LAS float* cB = cA + 1024;
    bf16_t* H1 = (bf16_t*)a.out;
    for (int rb = blockIdx.x; rb < TOK / 128; rb += gridDim.x) {
        const int b = rb / 32;
        __syncthreads();
        for (int j = tid; j < 1024; j += NTHREADS) { cA[j] = a.in[I_GPREMIX][j] * (1.f + ada_val(a, b, 1024 + j)); cB[j] = ada_val(a, b, j); }
        __syncthreads();
        if (wid >= 6) {
            if (rb == (int)blockIdx.x) phase0_weights(a, (LAS float*)(lds + 16384 + (wid - 6) * 8704), blockIdx.x * 2 + (wid - 6), gridDim.x * 2, lane);
        } else {
        for (int rr = wid; rr < 128; rr += 12) {
            const size_t row0 = (size_t)rb * 128 + rr; const bool two = (rr + 6 < 128);
            f32x4 v[2][4]; float s[2] = {0.f, 0.f};
#pragma unroll
            for (int q = 0; q < 2; ++q) { const f32x4* xr = (const f32x4*)(a.in[I_X] + (row0 + ((q && two) ? 6 : 0)) * DM) + lane;
#pragma unroll
                for (int j = 0; j < 4; ++j) v[q][j] = __builtin_nontemporal_load(xr + 64 * j); }
#pragma unroll
            for (int q = 0; q < 2; ++q) {
#pragma unroll
                for (int j = 0; j < 4; ++j) s[q] += (v[q][j].x * v[q][j].x + v[q][j].y * v[q][j].y) + (v[q][j].z * v[q][j].z + v[q][j].w * v[q][j].w);
                const float rstd = 1.0f / sqrtf(wave_sum(s[q]) * (1.f / DM) + RMS_EPS);
                if (q == 1 && !two) break;
                unsigned long long* o8 = (unsigned long long*)(H1 + (row0 + q * 6) * DM) + lane;
#pragma unroll
                for (int j = 0; j < 4; ++j) { const f32x4 ca = *(const LAS f32x4*)(cA + 4 * lane + 256 * j), cb = *(const LAS f32x4*)(cB + 4 * lane + 256 * j);
                    const f32x4 h = v[q][j] * rstd * ca + cb;
                    o8[64 * j] = (unsigned long long)pk2(h.x, h.y) | ((unsigned long long)pk2(h.z, h.w) << 32); }
            }
        }
        }
    }
}

__device__ __forceinline__ float tanh_f(float x) { const float e = __expf(2.f * x); return 1.f - 2.f * __builtin_amdgcn_rcpf(e + 1.f); }
__device__ __forceinline__ float sigm_f(float x) { return __builtin_amdgcn_rcpf(1.f + __expf(-x)); }
typedef short v4i16_t __attribute__((ext_vector_type(4)));
__device__ __forceinline__ s16x4 vtr(const LAS unsigned char* p) { return __builtin_bit_cast(s16x4, __builtin_amdgcn_ds_read_tr16_b64_v4i16((LAS v4i16_t*)p)); }
__device__ __forceinline__ float prefix16(float x) { x += dppf<0x111>(x); x += dppf<0x112>(x); x += dppf<0x114>(x); x += dppf<0x118>(x); return x; }
__device__ __forceinline__ bf16x8 pack8(const float* v) { u32x4 w = (u32x4){pk2(v[0], v[1]), pk2(v[2], v[3]), pk2(v[4], v[5]), pk2(v[6], v[7])}; return __builtin_bit_cast(bf16x8, w); }
__device__ __forceinline__ bf16x8 pack4z(float a, float b, float c, float d) { u32x4 w = (u32x4){pk2(a, b), pk2(c, d), 0u, 0u}; return __builtin_bit_cast(bf16x8, w); }
__device__ __forceinline__ void phase3(const Args& a, LAS unsigned char* lds) {
    const int tid = threadIdx.x, lane = tid & 63, wid = __builtin_amdgcn_readfirstlane(tid >> 6);
    const bf16_t* PROJ = (const bf16_t*)(a.ws + WS_PROJ);
    const bf16_t* W2t = (const bf16_t*)(a.ws + WS_W2T); const bf16_t* A2t = (const bf16_t*)(a.ws + WS_A2T); const bf16_t* G2t = (const bf16_t*)(a.ws + WS_G2T);
    constexpr int XP = 264;
    LAS bf16_t* Xs = (LAS bf16_t*)(lds + wid * 8448);
    LAS unsigned char* AIMG = lds + 67584 + wid * 3072;
    LAS float* ATL = (LAS float*)(AIMG + 2048);
    const int fr = lane & 15, fq = lane >> 4;
    LAS float* CT = (LAS float*)(lds + 92160);
    { const int ch = tid;
      CT[ch] = a.in[I_MUR][ch]; CT[512 + ch] = a.in[I_MUK][ch]; CT[1024 + ch] = a.in[I_MUV][ch]; CT[1536 + ch] = a.in[I_W0][ch];
      CT[2048 + ch] = a.in[I_A0][ch]; CT[2560 + ch] = a.in[I_KK][ch]; CT[3072 + ch] = a.in[I_KA][ch]; CT[3584 + ch] = a.in[I_RK][ch]; }
    LAS unsigned char* WB = lds + 108544;
    const unsigned char* wsrc; { const int p0 = wid * 4;
        wsrc = (p0 < 8) ? (const unsigned char*)W2t + p0 * 1024 : (p0 < 16) ? (const unsigned char*)A2t + (p0 - 8) * 1024 : (const unsigned char*)G2t + (p0 - 16) * 1024; }
    const int whs = (wid < 4) ? 8192 : 16384;
#define P3_WDMA(hd_) do { _Pragma("unroll") for (int q_ = 0; q_ < 4; ++q_) \
        __builtin_amdgcn_global_load_lds((const unsigned*)(wsrc + (size_t)(hd_) * whs + q_ * 1024 + lane * 16), (LAS unsigned*)(WB + (wid * 4 + q_) * 1024), 16, 0, 0); } while (0)
    __syncthreads();
    for (int tt = blockIdx.x * NWAVES + wid; tt < TOK / 16; tt += gridDim.x * NWAVES) {
        const int t0 = tt * 16;
        P3_WDMA(0);
        {
            const int xtok = lane >> 2, xp = lane & 3; const int tx = t0 + xtok; const bool hp = (tx % SEQ) != 0;
            const bf16_t* rc = PROJ + (size_t)tx * NPROJ; const bf16_t* rp = PROJ + (size_t)(tx - (hp ? 1 : 0)) * NPROJ;
#pragma unroll
            for (int jb = 0; jb < 2; ++jb) {
                u32x4 cw4[4], pw4[4];
#pragma unroll
                for (int jj = 0; jj < 4; ++jj) { const int j = 4 * jb + jj, j8 = (xp + 4 * j) * 8;
                    const int ccur = (j < 2) ? 3072 + j8 : (j < 4) ? 3200 + (j8 - 64) : 3328 + (j8 - 128), cprev = (j < 2) ? 3136 + j8 : (j < 4) ? 3264 + (j8 - 64) : 3456 + (j8 - 128);
                    cw4[jj] = *(const u32x4*)(rc + ccur); pw4[jj] = *(const u32x4*)(rp + cprev); if (!hp) pw4[jj] = (u32x4){0u, 0u, 0u, 0u}; }
#pragma unroll
                for (int jj = 0; jj < 4; ++jj) { const int j = 4 * jb + jj, j8 = (xp + 4 * j) * 8; unsigned o[4];
#pragma unroll
                    for (int i = 0; i < 4; ++i) { float lo = bflo(cw4[jj][i]) + bflo(pw4[jj][i]), hi = bfhi(cw4[jj][i]) + bfhi(pw4[jj][i]);
                        if (j < 2) { lo = tanh_f(lo); hi = tanh_f(hi); } else if (j >= 4) { lo = sigm_f(lo); hi = sigm_f(hi); }
                        o[i] = pk2(lo, hi); }
                    *(LAS u32x4*)(Xs + xtok * XP + j8) = (u32x4){o[0], o[1], o[2], o[3]}; }
            }
        }
        LDS_WAIT(); asm volatile("" ::: "memory");
        const int t = t0 + fr; const bool has_prev = (t % SEQ) != 0;
        const int bb = t0 / SEQ, cc = (t0 % SEQ) / 16;
        const bf16_t* prow = PROJ + (size_t)t * NPROJ; const bf16_t* pprev = PROJ + (size_t)(t - (has_prev ? 1 : 0)) * NPROJ;
#pragma unroll 1
        for (int hd = 0; hd < 8; ++hd) {
        if (hd == 0) asm volatile("s_waitcnt vmcnt(0)\n\ts_barrier" ::: "memory"); else asm volatile("s_waitcnt vmcnt(8)\n\ts_barrier" ::: "memory");
        unsigned char* ops = a.ws + WS_OPS + (size_t)((bb * 8 + hd) * 256 + cc) * OPS_STRIDE;
        if (a.flags & 4) ops = (unsigned char*)a.out + (size_t)(blockIdx.x * 8 + wid) * OPS_STRIDE;
        u32x2 prc[4], pkc[4], pvc[4], prp[4], pkp[4], pvp[4];
#pragma unroll
        for (int i = 0; i < 4; ++i) { const int ch = 64 * hd + 16 * i + 4 * fq;
            prc[i] = *(const u32x2*)(prow + 1536 + ch); pkc[i] = *(const u32x2*)(prow + 2048 + ch); pvc[i] = *(const u32x2*)(prow + 2560 + ch);
            prp[i] = *(const u32x2*)(pprev + 1536 + ch); pkp[i] = *(const u32x2*)(pprev + 2048 + ch); pvp[i] = *(const u32x2*)(pprev + 2560 + ch);
            if (!has_prev) { prp[i] = (u32x2){0u, 0u}; pkp[i] = prp[i]; pvp[i] = prp[i]; } }
        f32x4 lw[4], la[4];
        {   bf16x8 bx[8];
#pragma unroll
            for (int ks = 0; ks < 8; ++ks) bx[ks] = *(const LAS bf16x8*)(Xs + fr * XP + ks * 32 + fq * 8);
#pragma unroll
            for (int i = 0; i < 4; ++i) {
                f32x4 cw = (f32x4){0.f, 0.f, 0.f, 0.f}, ca = cw, cg_ = cw;
#pragma unroll
                for (int ks = 0; ks < 2; ++ks) { const bf16x8 af = *(const LAS bf16x8*)(WB + (16 * i + fr) * 128 + (ks * 32 + fq * 8) * 2); cw = __builtin_amdgcn_mfma_f32_16x16x32_bf16(af, bx[ks], cw, 0, 0, 0); }
#pragma unroll
                for (int ks = 0; ks < 2; ++ks) { const bf16x8 af = *(const LAS bf16x8*)(WB + 8192 + (16 * i + fr) * 128 + (ks * 32 + fq * 8) * 2); ca = __builtin_amdgcn_mfma_f32_16x16x32_bf16(af, bx[2 + ks], ca, 0, 0, 0); }
#pragma unroll
                for (int ks = 0; ks < 4; ++ks) { const bf16x8 af = *(const LAS bf16x8*)(WB + 16384 + (16 * i + fr) * 256 + (ks * 32 + fq * 8) * 2); cg_ = __builtin_amdgcn_mfma_f32_16x16x32_bf16(af, bx[4 + ks], cg_, 0, 0, 0); }
                lw[i] = cw; la[i] = ca;
                *(u32x2*)(ops + OP_G + (fr * 64 + 16 * i + 4 * fq) * 2) = (u32x2){pk2(cg_[0], cg_[1]), pk2(cg_[2], cg_[3])};
                asm volatile("" ::: "memory");
            }
        }
        float ssq = 0.f;
#pragma unroll
        for (int i = 0; i < 4; ++i) { const int ch = 64 * hd + 16 * i + 4 * fq;
            const f32x4 muk = *(const LAS f32x4*)(CT + 512 + ch), k_k = *(const LAS f32x4*)(CT + 2560 + ch);
#pragma unroll
            for (int e = 0; e < 4; ++e) { const float pk = (e & 1) ? bfhi(pkc[i][e >> 1]) : bflo(pkc[i][e >> 1]), pkv = (e & 1) ? bfhi(pkp[i][e >> 1]) : bflo(pkp[i][e >> 1]);
                const float kkr = (pk + (pkv - pk) * muk[e]) * k_k[e]; ssq += kkr * kkr; } }
        ssq += __shfl_xor(ssq, 16); ssq += __shfl_xor(ssq, 32);
        const float inv = 1.f / fmaxf(sqrtf(ssq), 1e-12f);
#pragma unroll
        for (int i = 0; i < 4; ++i) asm volatile("" :: "v"(prc[i]), "v"(pkc[i]), "v"(pvc[i]), "v"(prp[i]), "v"(pkp[i]), "v"(pvp[i]));
        asm volatile("s_waitcnt lgkmcnt(0)\n\ts_barrier" ::: "memory");
        if (hd < 7) P3_WDMA(hd + 1);
        f32x4 aab = (f32x4){0.f, 0.f, 0.f, 0.f}, aak = aab, arb = aab, ark = aab; float bon = 0.f;
#pragma unroll 1
        for (int s = 0; s < 2; ++s) {
            float r8[8], km8[8], kk8[8], b8[8], ld8[8];
#pragma unroll
            for (int ii = 0; ii < 2; ++ii) {
                const int i = 2 * s + ii;
                const f32x4 cw = lw[ii], ca = la[ii];
                const int chl = 16 * i + 4 * fq, ch = 64 * hd + chl;
                const f32x4 mur = *(const LAS f32x4*)(CT + ch), muk = *(const LAS f32x4*)(CT + 512 + ch), muv = *(const LAS f32x4*)(CT + 1024 + ch), w0 = *(const LAS f32x4*)(CT + 1536 + ch), a0 = *(const LAS f32x4*)(CT + 2048 + ch);
                const f32x4 k_k = *(const LAS f32x4*)(CT + 2560 + ch), k_a = *(const LAS f32x4*)(CT + 3072 + ch), r_k = *(const LAS f32x4*)(CT + 3584 + ch);
                float vv[4];
#pragma unroll
                for (int e = 0; e < 4; ++e) {
                    const float pr = (e & 1) ? bfhi(prc[ii][e >> 1]) : bflo(prc[ii][e >> 1]), prv = (e & 1) ? bfhi(prp[ii][e >> 1]) : bflo(prp[ii][e >> 1]);
                    const float pk = (e & 1) ? bfhi(pkc[ii][e >> 1]) : bflo(pkc[ii][e >> 1]), pkv = (e & 1) ? bfhi(pkp[ii][e >> 1]) : bflo(pkp[ii][e >> 1]);
                    const float pv = (e & 1) ? bfhi(pvc[ii][e >> 1]) : bflo(pvc[ii][e >> 1]), pvv = (e & 1) ? bfhi(pvp[ii][e >> 1]) : bflo(pvp[ii][e >> 1]);
                    const float r = pr + (prv - pr) * mur[e], k = pk + (pkv - pk) * muk[e]; vv[e] = pv + (pvv - pv) * muv[e];
                    const float z = w0[e] + cw[e];
                    const float sp = fmaxf(-z, 0.f) + __logf(1.f + __expf(-fabsf(z)));
                    const float wlog = -sp - 0.5f;
                    const float iclr = sigm_f(a0[e] + ca[e]);
                    const float kkn = k * k_k[e] * inv, km = k * (1.f + (iclr - 1.f) * k_a[e]);
                    r8[4 * ii + e] = r; km8[4 * ii + e] = km; kk8[4 * ii + e] = kkn; b8[4 * ii + e] = kkn * iclr; ld8[4 * ii + e] = -__expf(wlog);
                    bon += r * km * r_k[e];
                }
                *(u32x2*)(ops + OP_V + (fr * 64 + chl) * 2) = (u32x2){pk2(vv[0], vv[1]), pk2(vv[2], vv[3])};
            }
            float rt[8], at[8], bt[8], kt[8], bh[8], kh[8], gcv[8];
#pragma unroll
            for (int j = 0; j < 8; ++j) {
                const float cum = prefix16(ld8[j]); const float tot = __shfl(cum, (lane & 48) | 15);
                const float e1 = __expf(cum), e2 = __expf(-cum), e3 = __expf(cum - ld8[j]), e4 = __expf(tot - cum);
                rt[j] = r8[j] * e1; at[j] = -kk8[j] * e3; bt[j] = b8[j] * e2; kt[j] = km8[j] * e2; bh[j] = b8[j] * e4; kh[j] = km8[j] * e4; gcv[j] = e1;
            }
            const bf16x8 RT = pack8(rt), AT = pack8(at), BT = pack8(bt), KT = pack8(kt);
            *(bf16x8*)(ops + OP_RP + ((s * 16 + fr) * 4 + fq) * 16) = RT;
#pragma unroll
            for (int ii = 0; ii < 2; ++ii) { const int chl = 16 * (2 * s + ii) + 4 * fq;
                *(LAS u32x2*)(AIMG + (fr * 64 + chl) * 2) = (u32x2){pk2(at[4 * ii], at[4 * ii + 1]), pk2(at[4 * ii + 2], at[4 * ii + 3])};
                *(u32x2*)(ops + OP_BH + (fr * 64 + chl) * 2) = (u32x2){pk2(bh[4 * ii], bh[4 * ii + 1]), pk2(bh[4 * ii + 2], bh[4 * ii + 3])};
                *(u32x2*)(ops + OP_KH + (fr * 64 + chl) * 2) = (u32x2){pk2(kh[4 * ii], kh[4 * ii + 1]), pk2(kh[4 * ii + 2], kh[4 * ii + 3])};
                if (fr == 15) *(f32x4*)(ops + OP_GC + chl * 4) = (f32x4){gcv[4 * ii], gcv[4 * ii + 1], gcv[4 * ii + 2], gcv[4 * ii + 3]}; }
            aab = __builtin_amdgcn_mfma_f32_16x16x32_bf16(AT, BT, aab, 0, 0, 0); aak = __builtin_amdgcn_mfma_f32_16x16x32_bf16(AT, KT, aak, 0, 0, 0);
            arb = __builtin_amdgcn_mfma_f32_16x16x32_bf16(RT, BT, arb, 0, 0, 0); ark = __builtin_amdgcn_mfma_f32_16x16x32_bf16(RT, KT, ark, 0, 0, 0);
#pragma unroll
            for (int ii = 0; ii < 2; ++ii) { lw[ii] = lw[2 + ii]; la[ii] = la[2 + ii]; prc[ii] = prc[2 + ii]; pkc[ii] = pkc[2 + ii]; pvc[ii] = pvc[2 + ii]; prp[ii] = prp[2 + ii]; pkp[ii] = pkp[2 + ii]; pvp[ii] = pvp[2 + ii]; }
        }
        bon += __shfl_xor(bon, 16); bon += __shfl_xor(bon, 32);
        if (fq == 0) *(float*)(ops + OP_BON + fr * 4) = bon;
#pragma unroll
        for (int e = 0; e < 4; ++e) { const int tq = 4 * fq + e; if (!(fr < tq)) { aab[e] = 0.f; aak[e] = 0.f; } if (!(fr <= tq)) { arb[e] = 0.f; ark[e] = 0.f; } }
        *(u32x2*)(ops + OP_ARBT + (fr * 16 + 4 * fq) * 2) = (u32x2){pk2(arb[0], arb[1]), pk2(arb[2], arb[3])};
        *(u32x2*)(ops + OP_ARKT + (fr * 16 + 4 * fq) * 2) = (u32x2){pk2(ark[0], ark[1]), pk2(ark[2], ark[3])};
        *(LAS f32x4*)(ATL + fr * 16 + 4 * fq) = aab;
        LDS_WAIT(); asm volatile("" ::: "memory");
        float x[16];
#pragma unroll
        for (int m = 0; m < 16; ++m) x[m] = (m == fr) ? 1.f : 0.f;
#pragma unroll
        for (int j = 14; j >= 0; --j) {
            float acc = x[j];
#pragma unroll
            for (int mq = (j + 1) / 4; mq < 4; ++mq) { const f32x4 col = *(const LAS f32x4*)(ATL + j * 16 + 4 * mq);
#pragma unroll
                for (int e = 0; e < 4; ++e) { const int m = 4 * mq + e; if (m > j) acc += x[m] * col[e]; } }
            x[j] = acc;
        }
        float xs[4];
#pragma unroll
        for (int e = 0; e < 4; ++e) xs[e] = (fq == 0) ? x[e] : (fq == 1) ? x[4 + e] : (fq == 2) ? x[8 + e] : x[12 + e];
        const bf16x8 xa = pack4z(xs[0], xs[1], xs[2], xs[3]);
        {   const f32x4 z4 = __builtin_amdgcn_mfma_f32_16x16x32_bf16(xa, pack4z(aak[0], aak[1], aak[2], aak[3]), (f32x4){0.f, 0.f, 0.f, 0.f}, 0, 0, 0);
            *(u32x2*)(ops + OP_ZT + (fr * 16 + 4 * fq) * 2) = (u32x2){pk2(z4[0], z4[1]), pk2(z4[2], z4[3])}; }
#pragma unroll
        for (int kt = 0; kt < 4; ++kt) {
            const s16x4 tr = vtr(AIMG + ((4 * fq + (fr >> 2)) * 64 + 16 * kt + 4 * (fr & 3)) * 2);
            const bf16x8 bw = (bf16x8){tr[0], tr[1], tr[2], tr[3], 0, 0, 0, 0};
            const f32x4 w4 = __builtin_amdgcn_mfma_f32_16x16x32_bf16(xa, bw, (f32x4){0.f, 0.f, 0.f, 0.f}, 0, 0, 0);
            *(u32x2*)(ops + OP_WT + ((16 * kt + fr) * 16 + 4 * fq) * 2) = (u32x2){pk2(w4[0], w4[1]), pk2(w4[2], w4[3])};
        }
        LDS_WAIT(); asm volatile("" ::: "memory");
        }
    }
}

constexpr int SC_NS = 9, SC_D = 7, SC_YB = SC_NS * OPS_STRIDE;
__device__ __forceinline__ void scan_unit(const Args& a, LAS unsigned char* lds, int bh) {
    const int tid = threadIdx.x, lane = tid & 63; const int wid = __builtin_amdgcn_readfirstlane(tid >> 6);
    const int b = bh >> 3, h = bh & 7;
    const unsigned char* ops_base = a.ws + WS_OPS + (size_t)bh * 256 * OPS_STRIDE;
    bf16_t* YIN = (bf16_t*)((unsigned char*)a.out + 64 * MiB);
    constexpr int NCH = SEQ / 16;
    asm volatile("s_waitcnt vmcnt(0) lgkmcnt(0)\n\ts_barrier" ::: "memory");
    if (wid == 4 || wid == 5) {
        const int pw = (wid - 4) * 7;
#define SC_ISSUE(c) do { const unsigned char* g_ = ops_base + (size_t)(c) * OPS_STRIDE + (pw * 1024) + lane * 16; const int so_ = ((c) % SC_NS) * OPS_STRIDE + pw * 1024; \
        _Pragma("unroll") for (int p_ = 0; p_ < 7; ++p_) __builtin_amdgcn_global_load_lds((const unsigned*)(g_ + p_ * 1024), (LAS unsigned*)(lds + so_ + p_ * 1024), 16, 0, 0); } while (0)
        for (int c = 0; c < SC_D; ++c) SC_ISSUE(c);
        for (int c = 0; c < NCH; ++c) {
            if (c <= NCH - SC_D) asm volatile("s_waitcnt vmcnt(35)\n\ts_barrier" ::: "memory"); else asm volatile("s_waitcnt vmcnt(0)\n\ts_barrier" ::: "memory");
            if (c + SC_D < NCH) SC_ISSUE(c + SC_D);
        }
        asm volatile("s_waitcnt vmcnt(0)\n\ts_barrier" ::: "memory");
        asm volatile("s_barrier" ::: "memory");
#undef SC_ISSUE
    } else if (wid < 4) {
        const int vl = lane & 15, g = lane >> 4, i4 = (lane & 15) >> 2, p4 = lane & 3;
        f32x4 st[4];
#pragma unroll
        for (int kt = 0; kt < 4; ++kt) st[kt] = (f32x4){0.f, 0.f, 0.f, 0.f};
        const int trw = ((4 * g + i4) * 16 + 4 * p4) * 2;
        const int trk = ((4 * g + i4) * 64 + 4 * p4) * 2;
#define SC_FDECL(X) bf16x8 X##wa0, X##wa1, X##rp0, X##rp1; s16x4 X##zt, X##vt, X##ab, X##ak, X##bh0, X##bh1, X##bh2, X##bh3, X##kh0, X##kh1, X##kh2, X##kh3; f32x4 X##gc0, X##gc1, X##gc2, X##gc3
#define SC_FLOAD(X, c_) do { const LAS unsigned char* sl_ = lds + ((c_) % SC_NS) * OPS_STRIDE; \
        { const s16x4 a_ = vtr(sl_ + OP_WT + trw), b_ = vtr(sl_ + OP_WT + 16 * 32 + trw); X##wa0 = (bf16x8){a_[0], a_[1], a_[2], a_[3], b_[0], b_[1], b_[2], b_[3]}; } \
        { const s16x4 a_ = vtr(sl_ + OP_WT + 32 * 32 + trw), b_ = vtr(sl_ + OP_WT + 48 * 32 + trw); X##wa1 = (bf16x8){a_[0], a_[1], a_[2], a_[3], b_[0], b_[1], b_[2], b_[3]}; } \
        X##rp0 = *(const LAS bf16x8*)(sl_ + OP_RP + ((0 * 16 + vl) * 4 + g) * 16); X##rp1 = *(const LAS bf16x8*)(sl_ + OP_RP + ((1 * 16 + vl) * 4 + g) * 16); \
        X##zt = vtr(sl_ + OP_ZT + trw); X##vt = vtr(sl_ + OP_V + trk + 32 * wid); X##ab = vtr(sl_ + OP_ARBT + trw); X##ak = vtr(sl_ + OP_ARKT + trw); \
        X##bh0 = vtr(sl_ + OP_BH + trk); X##bh1 = vtr(sl_ + OP_BH + trk + 32); X##bh2 = vtr(sl_ + OP_BH + trk + 64); X##bh3 = vtr(sl_ + OP_BH + trk + 96); \
        X##kh0 = vtr(sl_ + OP_KH + trk); X##kh1 = vtr(sl_ + OP_KH + trk + 32); X##kh2 = vtr(sl_ + OP_KH + trk + 64); X##kh3 = vtr(sl_ + OP_KH + trk + 96); \
        X##gc0 = *(const LAS f32x4*)(sl_ + OP_GC + (4 * g) * 4); X##gc1 = *(const LAS f32x4*)(sl_ + OP_GC + (16 + 4 * g) * 4); X##gc2 = *(const LAS f32x4*)(sl_ + OP_GC + (32 + 4 * g) * 4); X##gc3 = *(const LAS f32x4*)(sl_ + OP_GC + (48 + 4 * g) * 4); } while (0)
#define SC_STEP(X, c_) do { bf16x8 sb0_, sb1_; \
        { u32x4 w_ = (u32x4){pk2(st[0][0], st[0][1]), pk2(st[0][2], st[0][3]), pk2(st[1][0], st[1][1]), pk2(st[1][2], st[1][3])}; sb0_ = __builtin_bit_cast(bf16x8, w_); } \
        { u32x4 w_ = (u32x4){pk2(st[2][0], st[2][1]), pk2(st[2][2], st[2][3]), pk2(st[3][0], st[3][1]), pk2(st[3][2], st[3][3])}; sb1_ = __builtin_bit_cast(bf16x8, w_); } \
        f32x4 u_ = (f32x4){0.f, 0.f, 0.f, 0.f}, y_ = u_; \
        u_ = __builtin_amdgcn_mfma_f32_16x16x32_bf16(X##wa0, sb0_, u_, 0, 0, 0); u_ = __builtin_amdgcn_mfma_f32_16x16x32_bf16(X##wa1, sb1_, u_, 0, 0, 0); \
        u_ = __builtin_amdgcn_mfma_f32_16x16x32_bf16((bf16x8){X##zt[0], X##zt[1], X##zt[2], X##zt[3], 0, 0, 0, 0}, (bf16x8){X##vt[0], X##vt[1], X##vt[2], X##vt[3], 0, 0, 0, 0}, u_, 0, 0, 0); \
        y_ = __builtin_amdgcn_mfma_f32_16x16x32_bf16(X##rp0, sb0_, y_, 0, 0, 0); y_ = __builtin_amdgcn_mfma_f32_16x16x32_bf16(X##rp1, sb1_, y_, 0, 0, 0); \
        bf16x8 uv_; { u32x2 uw_ = (u32x2){pk2(u_[0], u_[1]), pk2(u_[2], u_[3])}; const s16x4 us_ = __builtin_bit_cast(s16x4, uw_); uv_ = (bf16x8){us_[0], us_[1], us_[2], us_[3], X##vt[0], X##vt[1], X##vt[2], X##vt[3]}; } \
        st[0] = __builtin_amdgcn_mfma_f32_16x16x32_bf16((bf16x8){X##bh0[0], X##bh0[1], X##bh0[2], X##bh0[3], X##kh0[0], X##kh0[1], X##kh0[2], X##kh0[3]}, uv_, st[0] * X##gc0, 0, 0, 0); \
        st[1] = __builtin_amdgcn_mfma_f32_16x16x32_bf16((bf16x8){X##bh1[0], X##bh1[1], X##bh1[2], X##bh1[3], X##kh1[0], X##kh1[1], X##kh1[2], X##kh1[3]}, uv_, st[1] * X##gc1, 0, 0, 0); \
        st[2] = __builtin_amdgcn_mfma_f32_16x16x32_bf16((bf16x8){X##bh2[0], X##bh2[1], X##bh2[2], X##bh2[3], X##kh2[0], X##kh2[1], X##kh2[2], X##kh2[3]}, uv_, st[2] * X##gc2, 0, 0, 0); \
        st[3] = __builtin_amdgcn_mfma_f32_16x16x32_bf16((bf16x8){X##bh3[0], X##bh3[1], X##bh3[2], X##bh3[3], X##kh3[0], X##kh3[1], X##kh3[2], X##kh3[3]}, uv_, st[3] * X##gc3, 0, 0, 0); \
        y_ = __builtin_amdgcn_mfma_f32_16x16x32_bf16((bf16x8){X##ab[0], X##ab[1], X##ab[2], X##ab[3], X##ak[0], X##ak[1], X##ak[2], X##ak[3]}, uv_, y_, 0, 0, 0); \
        LAS float* yb_ = (LAS float*)(lds + SC_YB + ((c_) & 1) * 4096) + 16 * wid + vl; \
        _Pragma("unroll") for (int e = 0; e < 4; ++e) yb_[(4 * g + e) * 64] = y_[e]; } while (0)
        SC_FDECL(fa_); SC_FDECL(fb_);
        for (int c = 0; c < NCH; c += 2) {
            asm volatile("s_waitcnt lgkmcnt(0)\n\ts_barrier" ::: "memory");
            if (c == 0) SC_FLOAD(fa_, 0);
            SC_FLOAD(fb_, c + 1);
            SC_STEP(fa_, c);
            asm volatile("s_waitcnt lgkmcnt(0)\n\ts_barrier" ::: "memory");
            if (c + 2 < NCH) SC_FLOAD(fa_, c + 2);
            SC_STEP(fb_, c + 1);
        }
#undef SC_FDECL
#undef SC_FLOAD
#undef SC_STEP
        asm volatile("s_waitcnt lgkmcnt(0)\n\ts_barrier" ::: "memory");
        asm volatile("s_barrier" ::: "memory");
    } else {
        const int pi = tid - 384, ptk = pi >> 3, pc8 = (pi & 7) * 8;
        const f32x4 lg0 = *(const f32x4*)(a.in[I_LNXG] + h * 64 + pc8), lg1 = *(const f32x4*)(a.in[I_LNXG] + h * 64 + pc8 + 4), lb0 = *(const f32x4*)(a.in[I_LNXB] + h * 64 + pc8), lb1 = *(const f32x4*)(a.in[I_LNXB] + h * 64 + pc8 + 4);
#define SC_POST(cc) do { const LAS unsigned char* sl_ = lds + ((cc) % SC_NS) * OPS_STRIDE; const LAS float* yb_ = (const LAS float*)(lds + SC_YB + ((cc) & 1) * 4096) + ptk * 64 + pc8; \
        const f32x4 y0_ = *(const LAS f32x4*)yb_, y1_ = *(const LAS f32x4*)(yb_ + 4); \
        const float mean_ = sum8(((y0_[0] + y0_[1]) + (y0_[2] + y0_[3])) + ((y1_[0] + y1_[1]) + (y1_[2] + y1_[3]))) * (1.f / 64.f); \
        const f32x4 d0_ = y0_ - mean_, d1_ = y1_ - mean_; \
        const float var_ = sum8(((d0_[0] * d0_[0] + d0_[1] * d0_[1]) + (d0_[2] * d0_[2] + d0_[3] * d0_[3])) + ((d1_[0] * d1_[0] + d1_[1] * d1_[1]) + (d1_[2] * d1_[2] + d1_[3] * d1_[3]))) * (1.f / 64.f); \
        const float rstd_ = 1.0f / sqrtf(var_ + LNX_EPS); \
        const u32x4 vw_ = *(const LAS u32x4*)(sl_ + OP_V + (ptk * 64 + pc8) * 2), gw_ = *(const LAS u32x4*)(sl_ + OP_G + (ptk * 64 + pc8) * 2); \
        const float bon_ = *(const LAS float*)(sl_ + OP_BON + ptk * 4); \
        const f32x4 v0_ = (f32x4){bflo(vw_[0]), bfhi(vw_[0]), bflo(vw_[1]), bfhi(vw_[1])}, v1_ = (f32x4){bflo(vw_[2]), bfhi(vw_[2]), bflo(vw_[3]), bfhi(vw_[3])}; \
        const f32x4 g0_ = (f32x4){bflo(gw_[0]), bfhi(gw_[0]), bflo(gw_[1]), bfhi(gw_[1])}, g1_ = (f32x4){bflo(gw_[2]), bfhi(gw_[2]), bflo(gw_[3]), bfhi(gw_[3])}; \
        const f32x4 o0_ = (d0_ * rstd_ * lg0 + lb0 + bon_ * v0_) * g0_, o1_ = (d1_ * rstd_ * lg1 + lb1 + bon_ * v1_) * g1_; \
        const size_t t_ = (size_t)b * SEQ + (size_t)(cc) * 16 + ptk; \
        *(u32x4*)(YIN + t_ * 1024 + 512 + h * 64 + pc8) = (u32x4){pk2(o0_[0], o0_[1]), pk2(o0_[2], o0_[3]), pk2(o1_[0], o1_[1]), pk2(o1_[2], o1_[3])}; } while (0)
        for (int c = 0; c < NCH; ++c) {
            asm volatile("s_waitcnt lgkmcnt(0)\n\ts_barrier" ::: "memory");
            if (c > 0) SC_POST(c - 1);
        }
        asm volatile("s_waitcnt lgkmcnt(0)\n\ts_barrier" ::: "memory");
        SC_POST(NCH - 1);
        asm volatile("s_waitcnt lgkmcnt(0)\n\ts_barrier" ::: "memory");
#undef SC_POST
    }
}

constexpr int AT_SLOT = 32768;
constexpr int AT_WSF = 4 * AT_SLOT;
constexpr int AT_XP = 132;
constexpr float AT_THR = 8.f;
#define MFMA16(A, B, C) __builtin_amdgcn_mfma_f32_16x16x32_bf16(A, B, C, 0, 0, 0)
__device__ __forceinline__ float max_over_rows(float m) {
    { auto r = __builtin_amdgcn_permlane16_swap(__float_as_uint(m), __float_as_uint(m), false, false); m = fmaxf(__uint_as_float(r[0]), __uint_as_float(r[1])); }
    { auto r = __builtin_amdgcn_permlane32_swap(__float_as_uint(m), __float_as_uint(m), false, false); m = fmaxf(__uint_as_float(r[0]), __uint_as_float(r[1])); }
    return m;
}
__device__ __forceinline__ void attn_unit(const Args& a, LAS unsigned char* lds, int b, int h, int u, float lam) {
    const int tid = threadIdx.x, lane = tid & 63, c16 = lane & 15, g = lane >> 4; const int wid = __builtin_amdgcn_readfirstlane(tid >> 6);
    const int comp = wid >> 2, wq = wid & 3;
    const bf16_t* PROJ = (const bf16_t*)(a.ws + WS_PROJ);
    bf16_t* YIN = (bf16_t*)((unsigned char*)a.out + 64 * MiB);
    const size_t rowbase = (size_t)b * SEQ; const int q0 = u * 128;
    const int NT = 2 * u + 2;
    const int ntw = (q0 + 32 * wq) / 64 + 1;
    LAS float* wsf = (LAS float*)(lds + AT_WSF) + wid * 64;
    const bf16_t* ksrc0 = PROJ + (rowbase + lane) * NPROJ + 512 + h * 128 + wid * 8;
    const bf16_t* vsrc0 = PROJ + (rowbase + 16 * (wid & 3) + (lane >> 2)) * NPROJ + 1024 + h * 128 + (wid >> 2) * 32 + (lane & 3) * 8;
#define AT_DMA(t) do { const size_t ro_ = (size_t)(t) * 64 * NPROJ; LAS unsigned char* S_ = lds + ((t) & 3) * AT_SLOT + wid * 1024; \
        __builtin_amdgcn_global_load_lds((const unsigned*)(ksrc0 + ro_), (LAS unsigned*)(S_), 16, 0, 0); \
        __builtin_amdgcn_global_load_lds((const unsigned*)(ksrc0 + ro_ + 64), (LAS unsigned*)(S_ + 8192), 16, 0, 0); \
        __builtin_amdgcn_global_load_lds((const unsigned*)(vsrc0 + ro_), (LAS unsigned*)(S_ + 16384), 16, 0, 0); \
        __builtin_amdgcn_global_load_lds((const unsigned*)(vsrc0 + ro_ + 64), (LAS unsigned*)(S_ + 16384 + 8192), 16, 0, 0); } while (0)
    asm volatile("s_waitcnt vmcnt(0) lgkmcnt(0)\n\ts_barrier" ::: "memory");
    const bf16_t* Qw = PROJ + (rowbase + q0 + 32 * wq + c16) * NPROJ + h * 128 + comp * 64 + 8 * g;
    bf16x8 qf[2][2];
#pragma unroll
    for (int rb = 0; rb < 2; ++rb)
#pragma unroll
        for (int s = 0; s < 2; ++s) qf[rb][s] = *(const bf16x8*)(Qw + (size_t)(16 * rb) * NPROJ + 32 * s);
    asm volatile("s_waitcnt vmcnt(0)" : "+v"(qf[0][0]), "+v"(qf[0][1]), "+v"(qf[1][0]), "+v"(qf[1][1]) :: "memory");
    AT_DMA(0);
    if (NT > 1) AT_DMA(1);
    if (NT > 2) AT_DMA(2);
    f32x4 o[2][8], lacc[2];
#pragma unroll
    for (int rb = 0; rb < 2; ++rb) { lacc[rb] = (f32x4){0.f, 0.f, 0.f, 0.f};
#pragma unroll
        for (int n = 0; n < 8; ++n) o[rb][n] = (f32x4){0.f, 0.f, 0.f, 0.f}; }
    float mhat[2] = {0.f, 0.f};
    const int qi0 = q0 + 32 * wq + c16;
    const int koff = comp * 8192 + g * 1024 + c16 * 16;
    const int voff = 16384 + (4 * g + (c16 >> 2)) * 64 + (c16 & 3) * 8;
    const bf16x8 ones = (bf16x8){0x3F80, 0x3F80, 0x3F80, 0x3F80, 0x3F80, 0x3F80, 0x3F80, 0x3F80};
    if (NT > 2) asm volatile("s_waitcnt vmcnt(8)\n\ts_barrier" ::: "memory"); else if (NT > 1) asm volatile("s_waitcnt vmcnt(4)\n\ts_barrier" ::: "memory"); else asm volatile("s_waitcnt vmcnt(0)\n\ts_barrier" ::: "memory");
    for (int t = 0; t < NT; ++t) {
        if (t + 3 < NT) AT_DMA(t + 3);
        if (t < ntw) {
            const LAS unsigned char* Kb = lds + (t & 3) * AT_SLOT + koff;
            const LAS unsigned char* Vb = lds + (t & 3) * AT_SLOT + voff;
            f32x4 st[2][4];
#pragma unroll
            for (int rb = 0; rb < 2; ++rb)
#pragma unroll
                for (int kt = 0; kt < 4; ++kt) st[rb][kt] = (f32x4){-mhat[rb], -mhat[rb], -mhat[rb], -mhat[rb]};
#pragma unroll
            for (int s = 0; s < 2; ++s)
#pragma unroll
                for (int kt = 0; kt < 4; ++kt) { const bf16x8 kf = *(const LAS bf16x8*)(Kb + s * 4096 + kt * 256);
                    st[0][kt] = MFMA16(kf, qf[0][s], st[0][kt]); st[1][kt] = MFMA16(kf, qf[1][s], st[1][kt]); }
            const int kv0 = t * 64;
            if (kv0 + 63 > q0 + 32 * wq) {
#pragma unroll
                for (int kt = 0; kt < 4; ++kt)
#pragma unroll
                    for (int e = 0; e < 4; ++e) { const int kv = kv0 + 16 * kt + 4 * g + e; if (kv > qi0) st[0][kt][e] = -INFINITY; if (kv > qi0 + 16) st[1][kt][e] = -INFINITY; }
            }
            float rm[2];
#pragma unroll
            for (int rb = 0; rb < 2; ++rb) { float m = fmaxf(fmaxf(st[rb][0][0], st[rb][0][1]), fmaxf(st[rb][0][2], st[rb][0][3]));
#pragma unroll
                for (int kt = 1; kt < 4; ++kt) m = fmaxf(fmaxf(m, st[rb][kt][0]), fmaxf(fmaxf(st[rb][kt][1], st[rb][kt][2]), st[rb][kt][3]));
                rm[rb] = max_over_rows(m); }
            if (t == 0 || __any(fmaxf(rm[0], rm[1]) > AT_THR)) {
#pragma unroll
                for (int rb = 0; rb < 2; ++rb) {
                    const float dl = (t == 0) ? rm[rb] : fmaxf(rm[rb], 0.f);
                    mhat[rb] += dl;
#pragma unroll
                    for (int kt = 0; kt < 4; ++kt) st[rb][kt] = st[rb][kt] - dl;
                    if (g == 0) wsf[16 * rb + c16] = __builtin_amdgcn_exp2f(-dl);
                }
                if (t != 0) {
                    LDS_WAIT();
#pragma unroll
                    for (int rb = 0; rb < 2; ++rb) { const f32x4 f4 = *(const LAS f32x4*)(wsf + 16 * rb + 4 * g);
                        lacc[rb] = lacc[rb] * f4;
#pragma unroll
                        for (int n = 0; n < 8; ++n) o[rb][n] = o[rb][n] * f4; }
                }
                LDS_WAIT();
            }
            bf16x8 pa[2][2];
#pragma unroll
            for (int rb = 0; rb < 2; ++rb) {
#pragma unroll
                for (int kt = 0; kt < 4; ++kt)
#pragma unroll
                    for (int e = 0; e < 4; ++e) st[rb][kt][e] = __builtin_amdgcn_exp2f(st[rb][kt][e]);
#pragma unroll
                for (int sp = 0; sp < 2; ++sp) { const f32x4 x0 = st[rb][2 * sp], x1 = st[rb][2 * sp + 1];
                    u32x4 w = (u32x4){pk2(x0[0], x0[1]), pk2(x0[2], x0[3]), pk2(x1[0], x1[1]), pk2(x1[2], x1[3])}; pa[rb][sp] = __builtin_bit_cast(bf16x8, w); }
            }
#pragma unroll
            for (int rb = 0; rb < 2; ++rb)
#pragma unroll
                for (int sp = 0; sp < 2; ++sp) lacc[rb] = MFMA16(pa[rb][sp], ones, lacc[rb]);
#pragma unroll
            for (int n = 0; n < 8; ++n)
#pragma unroll
                for (int sp = 0; sp < 2; ++sp) {
                    const LAS unsigned char* vp = Vb + (n >> 1) * 4096 + (n & 1) * 32 + sp * 2048;
                    const s16x4 lo = vtr(vp), hv = vtr(vp + 1024);
                    const bf16x8 vf = (bf16x8){lo[0], lo[1], lo[2], lo[3], hv[0], hv[1], hv[2], hv[3]};
                    o[0][n] = MFMA16(pa[0][sp], vf, o[0][n]); o[1][n] = MFMA16(pa[1][sp], vf, o[1][n]);
                }
        }
        if (t + 3 < NT) asm volatile("s_waitcnt vmcnt(8) lgkmcnt(0)\n\ts_barrier" ::: "memory");
        else if (t + 2 < NT) asm volatile("s_waitcnt vmcnt(4) lgkmcnt(0)\n\ts_barrier" ::: "memory");
        else asm volatile("s_waitcnt vmcnt(0) lgkmcnt(0)\n\ts_barrier" ::: "memory");
    }
    LAS float* Xt = (LAS float*)lds + wq * (32 * AT_XP);
    if (comp == 1) {
#pragma unroll
        for (int rb = 0; rb < 2; ++rb)
#pragma unroll
            for (int e = 0; e < 4; ++e) { const float rl = 1.0f / lacc[rb][e];
#pragma unroll
                for (int n = 0; n < 8; ++n) Xt[(16 * rb + 4 * g + e) * AT_XP + 16 * n + c16] = o[rb][n][e] * rl; }
    }
    __syncthreads();
    if (comp == 0) {
#pragma unroll
        for (int rb = 0; rb < 2; ++rb)
#pragma unroll
            for (int e = 0; e < 4; ++e) { const float rl = 1.0f / lacc[rb][e];
#pragma unroll
                for (int n = 0; n < 8; ++n) { LAS float* p = Xt + (16 * rb + 4 * g + e) * AT_XP + 16 * n + c16; *p = o[rb][n][e] * rl - lam * (*p); } }
        LDS_WAIT(); asm volatile("" ::: "memory");
        const int row = lane >> 1, half = lane & 1;
        const LAS float* rp = Xt + row * AT_XP + half * 64;
        f32x4 v[16]; float ss = 0.f;
#pragma unroll
        for (int i = 0; i < 16; ++i) { v[i] = *(const LAS f32x4*)(rp + 4 * i); ss += (v[i][0] * v[i][0] + v[i][1] * v[i][1]) + (v[i][2] * v[i][2] + v[i][3] * v[i][3]); }
        ss += __shfl_xor(ss, 1);
        const float rstd = 0.8f / sqrtf(ss * (1.f / 128.f) + SUBLN_EPS);
        const float* sg = a.in[I_SUBLN] + half * 64;
        bf16_t* op = YIN + (rowbase + q0 + 32 * wq + row) * 1024 + h * 128 + half * 64;
#pragma unroll
        for (int i = 0; i < 8; ++i) { const f32x4 g0 = *(const f32x4*)(sg + 8 * i), g1 = *(const f32x4*)(sg + 8 * i + 4); const f32x4 x0 = v[2 * i] * rstd * g0, x1 = v[2 * i + 1] * rstd * g1;
            *(u32x4*)(op + 8 * i) = (u32x4){pk2(x0[0], x0[1]), pk2(x0[2], x0[3]), pk2(x1[0], x1[1]), pk2(x1[2], x1[3])}; }
    }
    __syncthreads();
#undef AT_DMA
}
#undef MFMA16

__device__ __forceinline__ void phase4(const Args& a, LAS unsigned char* lds) {
    const int tid = threadIdx.x;
    if (!(a.flags & 1)) for (int bh = blockIdx.x; bh < 64; bh += gridDim.x) scan_unit(a, lds, bh);
    if (a.flags & 2) return;
    float lam;
    { const int l = tid & 63; const float s1 = wave_sum(a.in[I_LQ1][l] * a.in[I_LK1][l]), s2 = wave_sum(a.in[I_LQ2][l] * a.in[I_LK2][l]); lam = __expf(s1) - __expf(s2) + 0.2f; }
    unsigned* ctl = (unsigned*)(a.ws + WS_CTL);
    LAS unsigned* qslot = (LAS unsigned*)(lds + 147456 - 64);
    for (;;) {
        __syncthreads();
        if (tid == 0) *qslot = atomicAdd(ctl + CW_QUEUE, 1u);
        __syncthreads();
        const unsigned idx = *qslot;
        if (idx >= 1024u) break;
        const int u = 31 - (int)(idx >> 5), bh = (int)(idx & 31);
        attn_unit(a, lds, bh >> 2, bh & 3, u, lam);
    }
}

__device__ __forceinline__ void phase6(const Args& a, LAS unsigned char* lds) {
    const int tid = threadIdx.x, lane = tid & 63, wid = __builtin_amdgcn_readfirstlane(tid >> 6);
    LAS float* cG = (LAS float*)lds; LAS float* cA = cG + 1024; LAS float* cB = cA + 1024;
    const bf16_t* YM = (const bf16_t*)(a.ws + WS_YMIX); const float* SSQ = (const float*)(a.ws + WS_SSQ1);
    bf16_t* H2 = (bf16_t*)(a.ws + WS_H2);
    for (int rb = blockIdx.x; rb < TOK / 128; rb += gridDim.x) {
        const int b = rb / 32;
        __syncthreads();
        for (int j = tid; j < 1024; j += NTHREADS) { cG[j] = ada_val(a, b, 2048 + j) * a.in[I_GPOSTMIX][j]; cA[j] = a.in[I_GPREFFN][j] * (1.f + ada_val(a, b, 4096 + j)); cB[j] = ada_val(a, b, 3072 + j); }
        __syncthreads();
        for (int rr = wid; rr < 128; rr += 2 * NWAVES) {
            const size_t row0 = (size_t)rb * 128 + rr;
            f32x4 xv[2][4]; u32x2 yv[2][4]; float sq[2];
#pragma unroll
            for (int q = 0; q < 2; ++q) { const size_t row = row0 + q * NWAVES; sq[q] = (lane < 16) ? SSQ[row * 16 + lane] : 0.f;
                const f32x4* xr = (const f32x4*)(a.in[I_X] + row * DM) + lane; const u32x2* yr = (const u32x2*)(YM + row * DM) + lane;
#pragma unroll
                for (int j = 0; j < 4; ++j) { xv[q][j] = __builtin_nontemporal_load(xr + 64 * j); yv[q][j] = __builtin_nontemporal_load(yr + 64 * j); } }
#pragma unroll
            for (int q = 0; q < 2; ++q) { const size_t row = row0 + q * NWAVES;
                const float rstd0 = 1.0f / sqrtf(wave_sum(sq[q]) * (1.f / DM) + RMS_EPS);
                f32x4 v[4]; float s = 0.f;
#pragma unroll
                for (int j = 0; j < 4; ++j) { const u32x2 yw = yv[q][j]; const f32x4 y = (f32x4){bflo(yw[0]), bfhi(yw[0]), bflo(yw[1]), bfhi(yw[1])};
                    const f32x4 g = *(const LAS f32x4*)(cG + 4 * lane + 256 * j);
                    v[j] = xv[q][j] + g * y * rstd0; s += (v[j].x * v[j].x + v[j].y * v[j].y) + (v[j].z * v[j].z + v[j].w * v[j].w); }
                const float rstd = 1.0f / sqrtf(wave_sum(s) * (1.f / DM) + RMS_EPS);
                unsigned long long* o8 = (unsigned long long*)(H2 + row * DM) + lane;
#pragma unroll
                for (int j = 0; j < 4; ++j) {
                    const f32x4 ca = *(const LAS f32x4*)(cA + 4 * lane + 256 * j), cb = *(const LAS f32x4*)(cB + 4 * lane + 256 * j);
                    const f32x4 hh = v[j] * rstd * ca + cb;
                    o8[64 * j] = (unsigned long long)pk2(hh.x, hh.y) | ((unsigned long long)pk2(hh.z, hh.w) << 32); }
            }
        }
    }
}
__device__ __forceinline__ void phase9(const Args& a, LAS unsigned char* lds) {
    const int tid = threadIdx.x, lane = tid & 63, wid = __builtin_amdgcn_readfirstlane(tid >> 6);
    LAS float* cG = (LAS float*)lds; LAS float* cM = cG + 1024;
    const bf16_t* FF = (const bf16_t*)(a.ws + WS_F); const float* SSQ = (const float*)(a.ws + WS_SSQ2);
    const bf16_t* YM = (const bf16_t*)(a.ws + WS_YMIX); const float* SSQ1 = (const float*)(a.ws + WS_SSQ1);
    for (int rb = blockIdx.x; rb < TOK / 128; rb += gridDim.x) {
        const int b = rb / 32;
        __syncthreads();
        for (int j = tid; j < 1024; j += NTHREADS) { cG[j] = ada_val(a, b, 5120 + j) * a.in[I_GPOSTFFN][j]; cM[j] = ada_val(a, b, 2048 + j) * a.in[I_GPOSTMIX][j]; }
        __syncthreads();
        for (int rr = wid; rr < 128; rr += 2 * NWAVES) {
            const size_t row0 = (size_t)rb * 128 + rr;
            f32x4 xv[2][4]; u32x2 yv[2][4], mv[2][4]; float sq[2], sm[2];
#pragma unroll
            for (int q = 0; q < 2; ++q) { const size_t row = row0 + q * NWAVES; sq[q] = (lane < 16) ? SSQ[row * 16 + lane] : 0.f; sm[q] = (lane < 16) ? SSQ1[row * 16 + lane] : 0.f;
                const f32x4* xr = (const f32x4*)(a.in[I_X] + row * DM) + lane; const u32x2* yr = (const u32x2*)(FF + row * DM) + lane; const u32x2* mr = (const u32x2*)(YM + row * DM) + lane;
#pragma unroll
                for (int j = 0; j < 4; ++j) { xv[q][j] = __builtin_nontemporal_load(xr + 64 * j); yv[q][j] = __builtin_nontemporal_load(yr + 64 * j); mv[q][j] = __builtin_nontemporal_load(mr + 64 * j); } }
#pragma unroll
            for (int q = 0; q < 2; ++q) { const size_t row = row0 + q * NWAVES;
                const float rstd0 = 1.0f / sqrtf(wave_sum(sq[q]) * (1.f / DM) + RMS_EPS), rstdm = 1.0f / sqrtf(wave_sum(sm[q]) * (1.f / DM) + RMS_EPS);
                f32x4* orow = (f32x4*)(a.out + row * DM) + lane;
#pragma unroll
                for (int j = 0; j < 4; ++j) { const u32x2 yw = yv[q][j], mw = mv[q][j];
                    const f32x4 y = (f32x4){bflo(yw[0]), bfhi(yw[0]), bflo(yw[1]), bfhi(yw[1])}, m = (f32x4){bflo(mw[0]), bfhi(mw[0]), bflo(mw[1]), bfhi(mw[1])};
                    const f32x4 g = *(const LAS f32x4*)(cG + 4 * lane + 256 * j), gm = *(const LAS f32x4*)(cM + 4 * lane + 256 * j);
                    const f32x4 x1 = xv[q][j] + gm * m * rstdm;
                    __builtin_nontemporal_store(x1 + g * y * rstd0, orow + 64 * j); }
            }
        }
    }
}

#define XB_TMO      128
#define XB_XCNT(j)  (256  + 64 * (j))
#define XB_XSUB(j)  (1280 + 64 * (j))
#define XB_XGEN(j)  (2304 + 64 * (j))
#define XB_TOP      3328
#define XB_TOPGEN   3392
#define XCD_BAR_WORDS 3456
#define XB_SPIN_CAP (1u << 18)
__device__ __forceinline__ unsigned xb_ld(unsigned* p)              { return __hip_atomic_load(p, __ATOMIC_RELAXED, __HIP_MEMORY_SCOPE_AGENT); }
__device__ __forceinline__ unsigned xb_add(unsigned* p, unsigned v) { return __hip_atomic_fetch_add(p, v, __ATOMIC_RELAXED, __HIP_MEMORY_SCOPE_AGENT); }
__device__ __forceinline__ unsigned xb_xcc_id() { return (unsigned)__builtin_amdgcn_s_getreg((3 << 11) | 20) & 0xFu; }
#define XB_SPIN(cond, bar) do { unsigned _sp = 0; while (cond) { __builtin_amdgcn_s_sleep(1); \
    if ((++_sp & 255u) == 0u) { if (xb_ld(&(bar)[XB_TMO])) break; if (_sp > XB_SPIN_CAP) { atomicAdd(&(bar)[XB_TMO], 1u); break; } } } } while (0)
struct XcdBarrier { unsigned* bar; unsigned x; volatile LAS unsigned* st; };
__device__ __forceinline__ XcdBarrier xcd_barrier_post(unsigned* bar, volatile LAS unsigned* st) {
    XcdBarrier b; b.bar = bar; b.x = xb_xcc_id(); b.st = st;
    if (threadIdx.x == 0) (void)xb_add(&bar[XB_XCNT(b.x)], 1u);
    return b;
}
__device__ __forceinline__ void xcd_barrier_complete(unsigned* bar, unsigned x, unsigned& nloc, unsigned& nx) {
    const unsigned G = gridDim.x * gridDim.y * gridDim.z;
    unsigned sum, cnt, mine, sp = 0u;
    for (;;) {
        sum = 0u; cnt = 0u; mine = 0u;
#pragma unroll
        for (unsigned j = 0; j < 16; ++j) { const unsigned c = xb_ld(&bar[XB_XCNT(j)]); sum += c; cnt += (c > 0u) ? 1u : 0u; mine = (j == x) ? c : mine; }
        if (sum == G) break;
        __builtin_amdgcn_s_sleep(1);
        if ((++sp & 255u) == 0u) { if (xb_ld(&bar[XB_TMO])) break; if (sp > XB_SPIN_CAP) { atomicAdd(&bar[XB_TMO], 1u); break; } }
    }
    nloc = mine > 0u ? mine : 1u; nx = cnt > 0u ? cnt : 1u;
}
__device__ __forceinline__ void xcd_barrier(const XcdBarrier& b) {
    asm volatile("s_waitcnt vmcnt(0)" ::: "memory");
    __syncthreads();
    if (threadIdx.x == 0) {
        unsigned* bar = b.bar;
        __builtin_amdgcn_s_waitcnt(0);
        unsigned nloc = b.st[0], nx = b.st[1];
        if (nloc == 0u) { xcd_barrier_complete(bar, b.x, nloc, nx); b.st[0] = nloc; b.st[1] = nx; }
        const unsigned old = xb_add(&bar[XB_XSUB(b.x)], 1u);
        const unsigned gen = old / nloc;
        if (old + 1u == (gen + 1u) * nloc) {
            __builtin_amdgcn_fence(__ATOMIC_RELEASE, "agent");
            asm volatile("s_waitcnt vmcnt(0)" ::: "memory");
            const unsigned og = xb_add(&bar[XB_TOP], 1u);
            const unsigned tg = og / nx;
            if (og + 1u == (tg + 1u) * nx) xb_add(&bar[XB_TOPGEN], 1u);
            else XB_SPIN(xb_ld(&bar[XB_TOPGEN]) == tg, bar);
            __builtin_amdgcn_fence(__ATOMIC_ACQUIRE, "agent");
            xb_add(&bar[XB_XGEN(b.x)], 1u);
            asm volatile("s_waitcnt vmcnt(0)" ::: "memory");
        } else {
            XB_SPIN(xb_ld(&bar[XB_XGEN(b.x)]) == gen, bar);
            __builtin_amdgcn_fence(__ATOMIC_ACQUIRE, "agent");
            asm volatile("s_waitcnt vmcnt(0)" ::: "memory");
        }
    }
    __syncthreads();
}

constexpr int NPHASE = 10;
__global__ void __launch_bounds__(NTHREADS, 2) fwd(Args args) {
    extern __shared__ __attribute__((aligned(16))) unsigned char lds_raw[];
    LAS unsigned char* lds = (LAS unsigned char*)lds_raw;
    const int lo = args.ph_lo, hi = args.ph_hi;
    unsigned char* ws = args.ws;
    volatile LAS unsigned* bst = (volatile LAS unsigned*)(lds + LDS_BYTES - 32);
    if (threadIdx.x < 2) bst[threadIdx.x] = 0u;
    __syncthreads();
    XcdBarrier bar; bar.bar = (unsigned*)(ws + WS_CTL) + CW_BAR; bar.x = 0; bar.st = bst;
    if (hi - lo > 1) bar = xcd_barrier_post((unsigned*)(ws + WS_CTL) + CW_BAR, bst);
#define SEAM(k) do { if (IN(k) && IN((k) + 1)) { xcd_barrier(bar); } } while (0)
#ifndef PHMASK
#define PHMASK 0x3ff
#endif
#define IN(k) ((PHMASK >> (k) & 1) && lo <= (k) && (k) < hi)
    if (IN(0)) { phase0(args, lds); } SEAM(0);
    if (IN(1)) { phase1(args, lds); } SEAM(1);
    if (IN(2)) {
        pg8::Gemm g{(const bf16_t*)args.out, (const bf16_t*)(ws + WS_WEXT), TOK, NPROJ, DM}; pg8::StaticOrder S; S.init(TOK, NPROJ, gridDim.x, blockIdx.x);
        pg8::EpiBf16 E{(bf16_t*)(ws + WS_PROJ), NPROJ, 2, C2};
        pg8::gemm_phase<pg8::EpiBf16, pg8::StaticOrder, true, true>(lds, g, S, E);
    } SEAM(2);
    if (IN(3)) { phase3(args, lds); } SEAM(3);
    if (IN(4)) { phase4(args, lds); } SEAM(4);
    if (IN(5)) {
        pg8::Gemm g{(const bf16_t*)((unsigned char*)args.out + 64 * MiB), (const bf16_t*)(ws + WS_WOUT), TOK, DM, DM}; pg8::StaticOrder S; S.init(TOK, DM, gridDim.x, blockIdx.x);
        pg8::EpiBf16Ssq E{(bf16_t*)(ws + WS_YMIX), DM, (float*)(ws + WS_SSQ1)};
        pg8::gemm_phase<pg8::EpiBf16Ssq, pg8::StaticOrder, true, true>(lds, g, S, E);
    } SEAM(5);
    if (IN(6)) { phase6(args, lds); } SEAM(6);
    if (IN(7)) {
        pg8::Gemm g{(const bf16_t*)(ws + WS_H2), (const bf16_t*)(ws + WS_WGU), TOK, 2 * FFH, DM}; pg8::StaticOrder S; S.init(TOK, 2 * FFH, gridDim.x, blockIdx.x);
        pg8::EpiSwiGlu E{(bf16_t*)(ws + WS_HID), FFH};
        pg8::gemm_phase<pg8::EpiSwiGlu, pg8::StaticOrder, true, true>(lds, g, S, E);
    } SEAM(7);
    if (IN(8)) {
        pg8::Gemm g{(const bf16_t*)(ws + WS_HID), (const bf16_t*)(ws + WS_WDN), TOK, DM, FFH}; pg8::StaticOrder S; S.init(TOK, DM, gridDim.x, blockIdx.x);
        pg8::EpiBf16Ssq E{(bf16_t*)(ws + WS_F), DM, (float*)(ws + WS_SSQ2)};
        pg8::gemm_phase<pg8::EpiBf16Ssq, pg8::StaticOrder, true, true>(lds, g, S, E);
    } SEAM(8);
    if (IN(9)) { phase9(args, lds); }
#undef IN
#undef SEAM
}

extern "C" void kernel_launch(void* const* d_in, const int* in_sizes, int n_in, void* d_out, int out_size, void* d_ws, size_t ws_size, hipStream_t stream) {
    static int grid = 0;
    if (grid == 0) {
        if (n_in != 37 || out_size != TOK * DM || ws_size < WS_END) { fprintf(stderr, "kernel_launch: unexpected shapes (n_in %d out %d ws %zu)\n", n_in, out_size, ws_size); grid = -1; return; }
        int dev = 0, cus = 0, per_cu = 0;
        hipGetDevice(&dev); hipDeviceGetAttribute(&cus, hipDeviceAttributeMultiprocessorCount, dev);
        hipFuncSetAttribute((const void*)fwd, hipFuncAttributeMaxDynamicSharedMemorySize, LDS_BYTES);
        hipOccupancyMaxActiveBlocksPerMultiprocessor(&per_cu, (const void*)fwd, NTHREADS, LDS_BYTES);
        (void)hipGetLastError();
        if (per_cu < 1) { fprintf(stderr, "kernel_launch: occupancy query says %d blocks per CU\n", per_cu); per_cu = 1; }
        grid = cus;
        fprintf(stderr, "kernel_launch: cus %d per_cu %d grid %d ws %zu\n", cus, per_cu, grid, ws_size);
    }
    if (grid < 0) return;
    hipMemsetAsync((char*)d_ws + WS_CTL, 0, CTL_ZERO_BYTES, stream);
    Args a{};
    for (int i = 0; i < 37; ++i) a.in[i] = (const float*)d_in[i];
    a.out = (float*)d_out; a.ws = (unsigned char*)d_ws;
#if defined(PROBE_DOUBLE)
    for (int p = 0; p < NPHASE; ++p) { a.ph_lo = p; a.ph_hi = p + 1; a.flags = 0; hipLaunchKernelGGL(fwd, dim3(grid), dim3(NTHREADS), LDS_BYTES, stream, a);
        if ((PROBE_DOUBLE >> p) & 1) { if (p == 4) { hipMemsetAsync((char*)d_ws + WS_CTL, 0, CTL_ZERO_BYTES, stream); a.flags = PROBE_P4FLAGS; }
            hipLaunchKernelGGL(fwd, dim3(grid), dim3(NTHREADS), LDS_BYTES, stream, a); } }
#elif N_LAUNCH_MODE == 1
    a.ph_lo = 0; a.ph_hi = NPHASE;
    void* kargs[] = {&a};
    hipError_t e = hipLaunchCooperativeKernel((const void*)fwd, dim3(grid), dim3(NTHREADS), kargs, LDS_BYTES, stream);
    if (e != hipSuccess) fprintf(stderr, "cooperative launch failed: %s (grid %d)\n", hipGetErrorString(e), grid);
#else
    for (int p = 0; p < NPHASE; ++p) { a.ph_lo = p; a.ph_hi = p + 1; hipLaunchKernelGGL(fwd, dim3(grid), dim3(NTHREADS), LDS_BYTES, stream, a); }
#endif
}
```

```cpp
#include <hip/hip_runtime.h>
#include <hip/hip_cooperative_groups.h>
#include <cstdio>
#include <cstdint>
namespace cg = cooperative_groups;

#ifndef PROBE_P4FLAGS
#define PROBE_P4FLAGS 0
#endif
#ifndef N_LAUNCH_MODE
#define N_LAUNCH_MODE 1
#endif

#define LAS __attribute__((address_space(3)))
typedef unsigned short bf16_t;
typedef short bf16x8 __attribute__((ext_vector_type(8)));
typedef short s16x4 __attribute__((ext_vector_type(4)));
typedef float f32x2 __attribute__((ext_vector_type(2)));
typedef float f32x4 __attribute__((ext_vector_type(4)));
typedef float f32x16 __attribute__((ext_vector_type(16)));
typedef unsigned u32x2 __attribute__((ext_vector_type(2)));
typedef unsigned u32x4 __attribute__((ext_vector_type(4)));
typedef __bf16 bf16x2_t __attribute__((ext_vector_type(2)));

constexpr int NB = 8, SEQ = 4096, DM = 1024, TOK = NB * SEQ;
constexpr int NPROJ = 3584;
constexpr int FFH = 2816;
constexpr int NTHREADS = 512, NWAVES = 8;
constexpr int LDS_BYTES = 147456;
constexpr float C2 = 0.125f * 1.4426950408889634f;
constexpr float RMS_EPS = 1e-6f, SUBLN_EPS = 1e-5f, LNX_EPS = 64e-5f;

constexpr size_t MiB = 1u << 20;
constexpr size_t WS_CTL = 0, CTL_ZERO_BYTES = 64 * 1024;
constexpr size_t WS_WEXT = 1 * MiB;
constexpr size_t WS_WOUT = 8 * MiB;
constexpr size_t WS_WGU = 10 * MiB;
constexpr size_t WS_WDN = 21 * MiB;
constexpr size_t WS_W2T = 27 * MiB;
constexpr size_t WS_A2T = WS_W2T + 65536;
constexpr size_t WS_G2T = WS_A2T + 65536;
constexpr size_t WS_ADAP = 28 * MiB;
constexpr size_t WS_SSQ1 = 31 * MiB - 0;
constexpr size_t WS_BONUS = 33 * MiB;
constexpr size_t WS_SSQ2 = 34 * MiB;
constexpr size_t WS_PROJ = 36 * MiB;
constexpr size_t WS_H2 = WS_PROJ;
constexpr size_t WS_F = WS_PROJ + 64 * MiB;
constexpr size_t WS_SCAN = 260 * MiB;
constexpr size_t WS_YMIX = WS_SCAN;
constexpr size_t WS_HID = WS_SCAN + 64 * MiB;
constexpr size_t WS_END = 500 * MiB;
constexpr size_t WS_OPS = WS_SCAN;
constexpr int OPS_STRIDE = 14336;
constexpr int OP_RP = 0, OP_WT = 2048, OP_ZT = 4096, OP_ARBT = 4608, OP_ARKT = 5120, OP_BH = 5632, OP_KH = 7680, OP_V = 9728, OP_G = 11776, OP_GC = 13824, OP_BON = 14080;

constexpr int CW_QUEUE = 0;
constexpr int CW_BAR = 4096;

__device__ __forceinline__ unsigned pk2(float lo, float hi) { f32x2 v = {lo, hi}; bf16x2_t b = __builtin_convertvector(v, bf16x2_t); return __builtin_bit_cast(unsigned, b); }
__device__ __forceinline__ float bf2f(unsigned short h) { return __uint_as_float(((unsigned)h) << 16); }
__device__ __forceinline__ float bflo(unsigned w) { return __uint_as_float(w << 16); }
__device__ __forceinline__ float bfhi(unsigned w) { return __uint_as_float(w & 0xffff0000u); }
#define LDS_WAIT() asm volatile("s_waitcnt lgkmcnt(0)" ::: "memory")

namespace pg8 {
constexpr int BM = 256, BK = 64, HALF = 128, HTB = HALF * BK * 2, STAGE_BYTES = 8 * HTB, NXCD = 8, WGM = 8;
__host__ __device__ __forceinline__ int lds_byte(int r, int c) { const int st = (r >> 4) * 2 + (c >> 5), rr = r & 15, cc = c & 31, ob = rr * 64 + cc * 2; return st * 1024 + (ob ^ (((ob >> 9) & 1) << 5)); }
__host__ __device__ __forceinline__ void stage_rc(int b, int& R, int& C) { const int st = b / 1024, sb = b % 1024, swz = sb ^ (((sb >> 9) & 1) << 5); R = (st >> 1) * 16 + swz / 64; C = (st & 1) * 32 + (swz % 64) / 2; }
__host__ __device__ __forceinline__ int perm32(int rho) { const int n = rho >> 4, i = rho & 15; return 8 * (i >> 2) + 4 * n + (i & 3); }
struct Unit { int pm, pn; };
struct Gemm { const bf16_t* A; const bf16_t* Bt; int M, N, K; };
struct StaticOrder {
    int nM, nN, nwg, G, c;
    __host__ __device__ void init(int M, int N, int G_, int c_) { nM = M / BM; nN = N / BM; nwg = nM * nN; G = G_; c = c_; }
    __host__ __device__ bool next(int i, Unit& u) const {
        const long L = (long)i * G + c; if (L >= nwg) return false;
        int wgid = (int)L; { const int q = nwg / NXCD, r = nwg % NXCD, xcd = wgid % NXCD, off = wgid / NXCD; wgid = (xcd < r ? xcd * (q + 1) : r * (q + 1) + (xcd - r) * q) + off; }
        const int nig = WGM * nN, gid = wgid / nig, fm = gid * WGM, gsz = (nM - fm) < WGM ? (nM - fm) : WGM;
        u.pm = fm + ((wgid % nig) % gsz); u.pn = (wgid % nig) / gsz; return true;
    }
    __device__ __forceinline__ void a_ready(const Unit&) const {}
    __device__ __forceinline__ void done(const Unit&) const {}
};
struct EpiBf16 {
    static constexpr bool PERM = true, AFTER_DRAIN = false;
    bf16_t* O; int ldc; int scale_tiles; float scale0;
    __device__ __forceinline__ void operator()(const f32x4 (&acc)[2][2][4][2], const Unit& u, int wr, int wc, int fr, int fq) const {
        const int row0 = u.pm * BM + wr * 64 + fr; const int col0 = u.pn * BM + wc * 32 + 8 * fq;
        const float sc = (u.pn < scale_tiles) ? scale0 : 1.f;
#pragma unroll
        for (int ai = 0; ai < 2; ++ai)
#pragma unroll
            for (int m = 0; m < 4; ++m) { bf16_t* rowp = O + (size_t)(row0 + ai * HALF + m * 16) * ldc + col0;
#pragma unroll
                for (int bj = 0; bj < 2; ++bj) { const f32x4 v0 = acc[ai][bj][m][0] * sc, v1 = acc[ai][bj][m][1] * sc;
                    u32x4 w; w.x = pk2(v0[0], v0[1]); w.y = pk2(v0[2], v0[3]); w.z = pk2(v1[0], v1[1]); w.w = pk2(v1[2], v1[3]);
                    *(u32x4*)(rowp + bj * HALF) = w; } }
    }
};
struct EpiBf16Ssq {
    static constexpr bool PERM = true, AFTER_DRAIN = false;
    bf16_t* O; int ldc; float* ssq;
    __device__ __forceinline__ void operator()(const f32x4 (&acc)[2][2][4][2], const Unit& u, int wr, int wc, int fr, int fq) const {
        const int row0 = u.pm * BM + wr * 64 + fr; const int col0 = u.pn * BM + wc * 32 + 8 * fq;
#pragma unroll
        for (int ai = 0; ai < 2; ++ai)
#pragma unroll
            for (int m = 0; m < 4; ++m) { const int row = row0 + ai * HALF + m * 16; bf16_t* rowp = O + (size_t)row * ldc + col0; float s = 0.f;
#pragma unroll
                for (int bj = 0; bj < 2; ++bj) { const f32x4 v0 = acc[ai][bj][m][0], v1 = acc[ai][bj][m][1];
                    s += (v0[0] * v0[0] + v0[1] * v0[1]) + (v0[2] * v0[2] + v0[3] * v0[3]) + (v1[0] * v1[0] + v1[1] * v1[1]) + (v1[2] * v1[2] + v1[3] * v1[3]);
                    u32x4 w; w.x = pk2(v0[0], v0[1]); w.y = pk2(v0[2], v0[3]); w.z = pk2(v1[0], v1[1]); w.w = pk2(v1[2], v1[3]);
                    *(u32x4*)(rowp + bj * HALF) = w; }
                s += __shfl_xor(s, 16); s += __shfl_xor(s, 32);
                if (fq == 0) ssq[(size_t)row * 16 + u.pn * 4 + wc] = s; }
    }
};
struct EpiSwiGlu {
    static constexpr bool PERM = true, AFTER_DRAIN = false;
    bf16_t* O; int ldc;
    __device__ __forceinline__ void operator()(const f32x4 (&acc)[2][2][4][2], const Unit& u, int wr, int wc, int fr, int fq) const {
        const int row0 = u.pm * BM + wr * 64 + fr; const int col0 = u.pn * HALF + wc * 32 + 8 * fq;
#pragma unroll
        for (int ai = 0; ai < 2; ++ai)
#pragma unroll
            for (int m = 0; m < 4; ++m) { bf16_t* rowp = O + (size_t)(row0 + ai * HALF + m * 16) * ldc + col0; float h[8];
#pragma unroll
                for (int n = 0; n < 2; ++n)
#pragma unroll
                    for (int e = 0; e < 4; ++e) { const float g = acc[ai][0][m][n][e], up = acc[ai][1][m][n][e];
                        const float sg = g * __builtin_amdgcn_rcpf(1.f + __builtin_amdgcn_exp2f(-1.4426950408889634f * g)); h[n * 4 + e] = sg * up; }
                u32x4 w; w.x = pk2(h[0], h[1]); w.y = pk2(h[2], h[3]); w.z = pk2(h[4], h[5]); w.w = pk2(h[6], h[7]);
                *(u32x4*)rowp = w; }
    }
};

template <class Epi, class Sched, bool ALIGN_EPI = false, bool SP2 = false>
__device__ __forceinline__ void gemm_phase(LAS unsigned char* lds, const Gemm g, const Sched& S, const Epi& E) {
    const int tid = threadIdx.x, wid = __builtin_amdgcn_readfirstlane(tid >> 6), lane = tid & 63, wr = wid >> 2, wc = wid & 3, fr = lane & 15, fq = lane >> 4;
    const int K = g.K, nt = K / BK;
    unsigned voffA[2], voffB[2];
#pragma unroll
    for (int i = 0; i < 2; ++i) { int R, C; stage_rc(tid * 16 + i * 8192, R, C); const int Rb = Epi::PERM ? ((R & ~31) + perm32(R & 31)) : R;
        voffA[i] = (unsigned)(R * K + C) * 2u; voffB[i] = (unsigned)(Rb * K + C) * 2u; }
    const size_t kstep = (size_t)(BK * 2);
    const size_t hstep = (size_t)HALF * K * 2;
    const size_t tstep = 2 * hstep;
    const unsigned ldsw = (unsigned)wid * 1024u;
    const int aoff = lds_byte(wr * 64 + fr, fq * 8), boff = lds_byte(wc * 32 + fr, fq * 8);
#define PG8_SA(b, h) (((b) * 2 + (h)) * HTB)
#define PG8_SB(b, h) ((4 + (b) * 2 + (h)) * HTB)
#define PG8_STAGE(bufoff, gbase, voff) do { _Pragma("unroll") for (int _i = 0; _i < 2; ++_i) \
        __builtin_amdgcn_global_load_lds((const unsigned*)((const char*)(gbase) + (voff)[_i]), (LAS unsigned*)(lds + (bufoff) + ldsw + _i * 8192), 16, 0, 0); } while (0)
#define PG8_LDA(dst, b, h) do { _Pragma("unroll") for (int m = 0; m < 4; ++m) _Pragma("unroll") for (int k = 0; k < 2; ++k) dst[m][k] = *(const LAS bf16x8*)(lds + PG8_SA(b, h) + aoff + m * 2048 + k * 1024); } while (0)
#define PG8_LDB(dst, b, h) do { _Pragma("unroll") for (int n = 0; n < 2; ++n) _Pragma("unroll") for (int k = 0; k < 2; ++k) dst[n][k] = *(const LAS bf16x8*)(lds + PG8_SB(b, h) + boff + n * 2048 + k * 1024); } while (0)
#define PG8_MMA(ai, bj, At, Bt) do { __builtin_amdgcn_s_setprio(1); _Pragma("unroll") for (int m = 0; m < 4; ++m) _Pragma("unroll") for (int n = 0; n < 2; ++n) _Pragma("unroll") for (int k = 0; k < 2; ++k) \
        acc[ai][bj][m][n] = __builtin_amdgcn_mfma_f32_16x16x32_bf16(Bt[n][k], At[m][k], acc[ai][bj][m][n], 0, 0, 0); __builtin_amdgcn_s_setprio(0); } while (0)
#define PG8_WAIT_V(n) asm volatile("s_waitcnt vmcnt(" #n ")" ::: "memory")
#define PG8_WAIT_L(n) asm volatile("s_waitcnt lgkmcnt(" #n ")" ::: "memory")
#define PG8_BAR __builtin_amdgcn_s_barrier()
#define PG8_SCHED __builtin_amdgcn_sched_barrier(0)
    Unit cur, nxt; int ui = 0;
    if (!S.next(0, cur)) return;
    f32x4 acc[2][2][4][2];
#pragma unroll
    for (int a = 0; a < 2; ++a)
#pragma unroll
        for (int b = 0; b < 2; ++b)
#pragma unroll
            for (int m = 0; m < 4; ++m)
#pragma unroll
                for (int n = 0; n < 2; ++n) acc[a][b][m][n] = (f32x4){0.f, 0.f, 0.f, 0.f};
    bf16x8 At[4][2], B0[2][2], B1[2][2];
    const char* cA = (const char*)g.A + (size_t)cur.pm * tstep; const char* cB = (const char*)g.Bt + (size_t)cur.pn * tstep;
    S.a_ready(cur);
    if constexpr (SP2) {
        PG8_STAGE(PG8_SB(0, 0), cB, voffB); PG8_STAGE(PG8_SB(0, 1), cB + hstep, voffB); PG8_STAGE(PG8_SA(0, 0), cA, voffA); PG8_STAGE(PG8_SA(0, 1), cA + hstep, voffA);
        if (wr == 1) PG8_BAR;
        PG8_WAIT_V(2); PG8_BAR;
        PG8_STAGE(PG8_SB(1, 0), cB + kstep, voffB); PG8_STAGE(PG8_SA(1, 0), cA + kstep, voffA); PG8_STAGE(PG8_SB(1, 1), cB + hstep + kstep, voffB);
        PG8_WAIT_V(6); PG8_BAR;
    } else {
        PG8_STAGE(PG8_SB(0, 0), cB, voffB); PG8_STAGE(PG8_SA(0, 0), cA, voffA); PG8_STAGE(PG8_SB(0, 1), cB + hstep, voffB); PG8_STAGE(PG8_SA(0, 1), cA + hstep, voffA);
        if (wr == 1) PG8_BAR;
        PG8_WAIT_V(4); PG8_BAR;
        PG8_STAGE(PG8_SB(1, 0), cB + kstep, voffB); PG8_STAGE(PG8_SA(1, 0), cA + kstep, voffA); PG8_STAGE(PG8_SB(1, 1), cB + hstep + kstep, voffB);
        PG8_WAIT_V(6); PG8_BAR;
    }
    for (;;) {
        const bool has_next = S.next(ui + 1, nxt);
        const char* nA = has_next ? (const char*)g.A + (size_t)nxt.pm * tstep : cA; const char* nB = has_next ? (const char*)g.Bt + (size_t)nxt.pn * tstep : cB;
        for (int t = 0; t < nt; t += 2) {
            const bool last = (t == nt - 2);
            const char* a1 = cA + (size_t)(t + 1) * kstep;
            const char* a2 = last ? nA : cA + (size_t)(t + 2) * kstep; const char* b2 = last ? nB : cB + (size_t)(t + 2) * kstep;
            const char* a3 = a2 + kstep; const char* b3 = b2 + kstep;
            if (last && has_next) S.a_ready(nxt);
            if constexpr (SP2) {
            PG8_LDB(B0, 0, 0); PG8_LDB(B1, 0, 1); PG8_SCHED; PG8_LDA(At, 0, 0); PG8_STAGE(PG8_SA(1, 1), a1 + hstep, voffA);
            PG8_WAIT_V(8); PG8_WAIT_L(0); PG8_BAR; PG8_MMA(0, 0, At, B0); PG8_MMA(0, 1, At, B1); PG8_BAR; PG8_SCHED;
            PG8_LDA(At, 0, 1); PG8_STAGE(PG8_SB(0, 0), b2, voffB); PG8_STAGE(PG8_SB(0, 1), b2 + hstep, voffB); PG8_STAGE(PG8_SA(0, 0), a2, voffA);
            PG8_WAIT_V(8); PG8_WAIT_L(0); PG8_BAR; PG8_MMA(1, 0, At, B0); PG8_MMA(1, 1, At, B1); PG8_BAR; PG8_SCHED;
            PG8_LDB(B0, 1, 0); PG8_LDB(B1, 1, 1); PG8_SCHED; PG8_LDA(At, 1, 0); PG8_STAGE(PG8_SA(0, 1), a2 + hstep, voffA);
            PG8_WAIT_V(8); PG8_WAIT_L(0); PG8_BAR; PG8_MMA(0, 0, At, B0); PG8_MMA(0, 1, At, B1); PG8_BAR; PG8_SCHED;
            PG8_LDA(At, 1, 1); PG8_STAGE(PG8_SB(1, 0), b3, voffB); PG8_STAGE(PG8_SB(1, 1), b3 + hstep, voffB); PG8_STAGE(PG8_SA(1, 0), a3, voffA);
            PG8_WAIT_V(8); PG8_WAIT_L(0); PG8_BAR; PG8_MMA(1, 0, At, B0); PG8_MMA(1, 1, At, B1); PG8_BAR; PG8_SCHED;
            } else {
            PG8_LDB(B0, 0, 0); PG8_SCHED; PG8_LDA(At, 0, 0); PG8_STAGE(PG8_SA(1, 1), a1 + hstep, voffA);
            PG8_WAIT_L(8); PG8_BAR; PG8_WAIT_L(0); PG8_MMA(0, 0, At, B0); PG8_BAR; PG8_SCHED;
            PG8_LDB(B1, 0, 1); PG8_STAGE(PG8_SB(0, 0), b2, voffB);
            PG8_BAR; PG8_WAIT_L(0); PG8_MMA(0, 1, At, B1); PG8_BAR;
            PG8_LDA(At, 0, 1); PG8_STAGE(PG8_SA(0, 0), a2, voffA);
            PG8_BAR; PG8_WAIT_L(0); PG8_MMA(1, 0, At, B0); PG8_BAR; PG8_SCHED;
            PG8_STAGE(PG8_SB(0, 1), b2 + hstep, voffB);
            PG8_WAIT_V(6); PG8_BAR; PG8_MMA(1, 1, At, B1); PG8_BAR;
            PG8_LDB(B0, 1, 0); PG8_SCHED; PG8_LDA(At, 1, 0); PG8_STAGE(PG8_SA(0, 1), a2 + hstep, voffA);
            PG8_WAIT_L(8); PG8_BAR; PG8_WAIT_L(0); PG8_MMA(0, 0, At, B0); PG8_BAR; PG8_SCHED;
            PG8_LDB(B1, 1, 1); PG8_STAGE(PG8_SB(1, 0), b3, voffB);
            PG8_BAR; PG8_WAIT_L(0); PG8_MMA(0, 1, At, B1); PG8_BAR;
            PG8_LDA(At, 1, 1); PG8_STAGE(PG8_SA(1, 0), a3, voffA);
            PG8_BAR; PG8_WAIT_L(0); PG8_MMA(1, 0, At, B0); PG8_BAR; PG8_SCHED;
            PG8_STAGE(PG8_SB(1, 1), b3 + hstep, voffB);
            PG8_WAIT_V(6); PG8_BAR; PG8_MMA(1, 1, At, B1); PG8_BAR;
            }
        }
        if constexpr (ALIGN_EPI) { if (wr == 0) PG8_BAR; }
        if constexpr (!Epi::AFTER_DRAIN) { E(acc, cur, wr, wc, fr, fq); S.done(cur); }
        if (!has_next) break;
#pragma unroll
        for (int a = 0; a < 2; ++a)
#pragma unroll
            for (int b = 0; b < 2; ++b)
#pragma unroll
                for (int m = 0; m < 4; ++m)
#pragma unroll
                    for (int n = 0; n < 2; ++n) acc[a][b][m][n] = (f32x4){0.f, 0.f, 0.f, 0.f};
        cur = nxt; cA = nA; cB = nB; ++ui;
        if constexpr (ALIGN_EPI) { if (wr == 1) PG8_BAR; }
    }
    PG8_WAIT_V(0);
    if constexpr (!ALIGN_EPI) { if (wr == 0) PG8_BAR; }
    PG8_BAR;
#undef PG8_SA
#undef PG8_SB
#undef PG8_STAGE
#undef PG8_LDA
#undef PG8_LDB
#undef PG8_MMA
#undef PG8_WAIT_V
#undef PG8_WAIT_L
#undef PG8_BAR
#undef PG8_SCHED
}
}

struct Args {
    const float* in[37];
    float* out;
    unsigned char* ws;
    int ph_lo, ph_hi, flags, pad;
};
enum { I_X = 0, I_C, I_WADA, I_BADA, I_GPREMIX, I_GPOSTMIX, I_GPREFFN, I_GPOSTFFN, I_WIN, I_LQ1, I_LK1, I_LQ2, I_LK2, I_SUBLN, I_MUR, I_MUK, I_MUV, I_MUW, I_MUA, I_MUG,
       I_W0, I_W1, I_W2, I_A0, I_A1, I_A2, I_G1, I_G2, I_KK, I_KA, I_RK, I_LNXG, I_LNXB, I_WOUT, I_WGATE, I_WUP, I_WDOWN };

__device__ __forceinline__ float wave_sum(float v) {
#pragma unroll
    for (int o = 1; o < 64; o <<= 1) v += __shfl_xor(v, o);
    return v;
}
template <int CTRL> __device__ __forceinline__ float dppf(float x) { return __builtin_bit_cast(float, __builtin_amdgcn_update_dpp(0, __builtin_bit_cast(int, x), CTRL, 0xf, 0xf, true)); }
__device__ __forceinline__ float sum8(float v) { v += dppf<0xB1>(v); v += dppf<0x4E>(v); v += dppf<0x141>(v); return v; }
__device__ __forceinline__ float sum16(float v) { v = sum8(v); v += dppf<0x140>(v); return v; }

__device__ __forceinline__ void tr_item(const float* W, int K, int N, bf16_t* WT, int ldo, int dst_row0, LAS float* scr, int kb, int nb, int lane, const float* mu, int mode) {
    const int k0 = 64 * kb, n0 = 32 * nb;
#pragma unroll 8
    for (int i = 0; i < 32; ++i) { const int kk = 2 * i + (lane >> 5); float v = W[(size_t)(k0 + kk) * N + n0 + (lane & 31)];
        if (mode == 1) v *= (1.f - mu[k0 + kk]); else if (mode == 2) v *= mu[k0 + kk];
        scr[kk * 33 + (lane & 31)] = v; }
    LDS_WAIT(); asm volatile("" ::: "memory");
    const int c = lane & 7;
#pragma unroll
    for (int j = 0; j < 4; ++j) { const int n = (lane >> 3) + 8 * j; const LAS float* s = scr + (8 * c) * 33 + n;
        u32x4 o; o.x = pk2(s[0 * 33], s[1 * 33]); o.y = pk2(s[2 * 33], s[3 * 33]); o.z = pk2(s[4 * 33], s[5 * 33]); o.w = pk2(s[6 * 33], s[7 * 33]);
        *(u32x4*)(WT + (size_t)(dst_row0 + n) * ldo + k0 + 8 * c) = o; }
    LDS_WAIT(); asm volatile("" ::: "memory");
}

__device__ __forceinline__ void phase0(const Args& a, LAS unsigned char* lds) {
    const int tid = threadIdx.x, lane = tid & 63, wid = __builtin_amdgcn_readfirstlane(tid >> 6);
    const int G = gridDim.x;
    LAS float* scr = (LAS float*)(lds + wid * 8704);
    unsigned char* ws = a.ws;
    bf16_t* Wext = (bf16_t*)(ws + WS_WEXT); bf16_t* Wout = (bf16_t*)(ws + WS_WOUT); bf16_t* Wgu = (bf16_t*)(ws + WS_WGU); bf16_t* Wdn = (bf16_t*)(ws + WS_WDN);
    bf16_t* W2t = (bf16_t*)(ws + WS_W2T); bf16_t* A2t = (bf16_t*)(ws + WS_A2T); bf16_t* G2t = (bf16_t*)(ws + WS_G2T);
    const int gw = blockIdx.x * NWAVES + wid, NGW = G * NWAVES;
    constexpr int J0 = 1536, J1 = 32, J5 = 64, J7 = 512, J8 = 1408, J11 = 16, J13 = 32;
    constexpr int NITEMS = J0 + 4 * J1 + 2 * J5 + J7 + 3 * J8 + 2 * J11 + J13;
    for (int it = gw; it < NITEMS; it += NGW) {
        int r = it;
        if (r < J0) { tr_item(a.in[I_WIN], 1024, 3072, Wext, 1024, (r % 96) * 32, scr, r / 96, r % 96, lane, nullptr, 0); continue; } r -= J0;
        if (r < J1) { tr_item(a.in[I_W1], 1024, 64, Wext, 1024, 3072 + (r % 2) * 32, scr, r / 2, r % 2, lane, a.in[I_MUW], 1); continue; } r -= J1;
        if (r < J1) { tr_item(a.in[I_W1], 1024, 64, Wext, 1024, 3136 + (r % 2) * 32, scr, r / 2, r % 2, lane, a.in[I_MUW], 2); continue; } r -= J1;
        if (r < J1) { tr_item(a.in[I_A1], 1024, 64, Wext, 1024, 3200 + (r % 2) * 32, scr, r / 2, r % 2, lane, a.in[I_MUA], 1); continue; } r -= J1;
        if (r < J1) { tr_item(a.in[I_A1], 1024, 64, Wext, 1024, 3264 + (r % 2) * 32, scr, r / 2, r % 2, lane, a.in[I_MUA], 2); continue; } r -= J1;
        if (r < J5) { tr_item(a.in[I_G1], 1024, 128, Wext, 1024, 3328 + (r % 4) * 32, scr, r / 4, r % 4, lane, a.in[I_MUG], 1); continue; } r -= J5;
        if (r < J5) { tr_item(a.in[I_G1], 1024, 128, Wext, 1024, 3456 + (r % 4) * 32, scr, r / 4, r % 4, lane, a.in[I_MUG], 2); continue; } r -= J5;
        if (r < J7) { tr_item(a.in[I_WOUT], 1024, 1024, Wout, 1024, (r % 32) * 32, scr, r / 32, r % 32, lane, nullptr, 0); continue; } r -= J7;
        if (r < J8) { const int nb = r % 88, n0 = nb * 32; tr_item(a.in[I_WGATE], 1024, 2816, Wgu, 1024, 256 * (n0 / 128) + (n0 % 128), scr, r / 88, nb, lane, nullptr, 0); continue; } r -= J8;
        if (r < J8) { const int nb = r % 88, n0 = nb * 32; tr_item(a.in[I_WUP], 1024, 2816, Wgu, 1024, 256 * (n0 / 128) + (n0 % 128) + 128, scr, r / 88, nb, lane, nullptr, 0); continue; } r -= J8;
        if (r < J8) { tr_item(a.in[I_WDOWN], 2816, 1024, Wdn, 2816, (r % 32) * 32, scr, r / 32, r % 32, lane, nullptr, 0); continue; } r -= J8;
        if (r < J11) { tr_item(a.in[I_W2], 64, 512, W2t, 64, r * 32, scr, 0, r, lane, nullptr, 0); continue; } r -= J11;
        if (r < J11) { tr_item(a.in[I_A2], 64, 512, A2t, 64, r * 32, scr, 0, r, lane, nullptr, 0); continue; } r -= J11;
        tr_item(a.in[I_G2], 128, 512, G2t, 128, (r % 16) * 32, scr, r / 16, r % 16, lane, nullptr, 0);
    }
    LAS float* sc = (LAS float*)(lds + 73728);
    const float* cin = a.in[I_C];
    for (int i = tid; i < 8192; i += NTHREADS) { const float v = cin[i]; sc[i] = v * __builtin_amdgcn_rcpf(1.f + __expf(-v)); }
    __syncthreads();
    float* adap = (float*)(ws + WS_ADAP); const float* wada = a.in[I_WADA];
    for (int it = blockIdx.x * NTHREADS + tid; it < 16 * 6144; it += G * NTHREADS) {
        const int col = it % 6144, kc = it / 6144; float acc[8];
#pragma unroll
        for (int b = 0; b < 8; ++b) acc[b] = 0.f;
        for (int k = kc * 64; k < kc * 64 + 64; ++k) { const float w = wada[(size_t)k * 6144 + col];
#pragma unroll
            for (int b = 0; b < 8; ++b) acc[b] += sc[b * 1024 + k] * w; }
#pragma unroll
        for (int b = 0; b < 8; ++b) adap[(size_t)(kc * 8 + b) * 6144 + col] = acc[b];
    }
    __syncthreads();
}
__device__ __forceinline__ float ada_val(const Args& a, int b, int j) {
    const float* adap = (const float*)(a.ws + WS_ADAP); float s = a.in[I_BADA][j];
#pragma unroll
    for (int kc = 0; kc < 16; ++kc) s += adap[(size_t)(kc * 8 + b) * 6144 + j];
    return s;
}

__device__ __forceinline__ void phase1(const Args& a, LAS unsigned char* lds) {
    const int tid = threadIdx.x, lane = tid & 63, wid = __builtin_amdgcn_readfirstlane(tid >> 6);
    LAS float* cA = (LAS float*)lds; LAS float* cB = cA + 1024;
    bf16_t* H1 = (bf16_t*)a.out;
    for (int rb = blockIdx.x; rb < TOK / 128; rb += gridDim.x) {
        const int b = rb / 32;
        __syncthreads();
        for (int j = tid; j < 1024; j += NTHREADS) { cA[j] = a.in[I_GPREMIX][j] * (1.f + ada_val(a, b, 1024 + j)); cB[j] = ada_val(a, b, j); }
        __syncthreads();
        for (int rr = wid; rr < 128; rr += 2 * NWAVES) {
            const size_t row0 = (size_t)rb * 128 + rr;
            f32x4 v[2][4]; float s[2] = {0.f, 0.f};
#pragma unroll
            for (int q = 0; q < 2; ++q) { const f32x4* xr = (const f32x4*)(a.in[I_X] + (row0 + q * NWAVES) * DM) + lane;
#pragma unroll
                for (int j = 0; j < 4; ++j) v[q][j] = __builtin_nontemporal_load(xr + 64 * j); }
#pragma unroll
            for (int q = 0; q < 2; ++q) {
#pragma unroll
                for (int j = 0; j < 4; ++j) s[q] += (v[q][j].x * v[q][j].x + v[q][j].y * v[q][j].y) + (v[q][j].z * v[q][j].z + v[q][j].w * v[q][j].w);
                const float rstd = 1.0f / sqrtf(wave_sum(s[q]) * (1.f / DM) + RMS_EPS);
                unsigned long long* o8 = (unsigned long long*)(H1 + (row0 + q * NWAVES) * DM) + lane;
#pragma unroll
                for (int j = 0; j < 4; ++j) { const f32x4 ca = *(const LAS f32x4*)(cA + 4 * lane + 256 * j), cb = *(const LAS f32x4*)(cB + 4 * lane + 256 * j);
                    const f32x4 h = v[q][j] * rstd * ca + cb;
                    o8[64 * j] = (unsigned long long)pk2(h.x, h.y) | ((unsigned long long)pk2(h.z, h.w) << 32); }
            }
        }
    }
}

__device__ __forceinline__ float tanh_f(float x) { const float e = __expf(2.f * x); return 1.f - 2.f * __builtin_amdgcn_rcpf(e + 1.f); }
__device__ __forceinline__ float sigm_f(float x) { return __builtin_amdgcn_rcpf(1.f + __expf(-x)); }
typedef short v4i16_t __attribute__((ext_vector_type(4)));
__device__ __forceinline__ s16x4 vtr(const LAS unsigned char* p) { return __builtin_bit_cast(s16x4, __builtin_amdgcn_ds_read_tr16_b64_v4i16((LAS v4i16_t*)p)); }
__device__ __forceinline__ float prefix16(float x) { x += dppf<0x111>(x); x += dppf<0x112>(x); x += dppf<0x114>(x); x += dppf<0x118>(x); return x; }
__device__ __forceinline__ bf16x8 pack8(const float* v) { u32x4 w = (u32x4){pk2(v[0], v[1]), pk2(v[2], v[3]), pk2(v[4], v[5]), pk2(v[6], v[7])}; return __builtin_bit_cast(bf16x8, w); }
__device__ __forceinline__ bf16x8 pack4z(float a, float b, float c, float d) { u32x4 w = (u32x4){pk2(a, b), pk2(c, d), 0u, 0u}; return __builtin_bit_cast(bf16x8, w); }
__device__ __forceinline__ void phase3(const Args& a, LAS unsigned char* lds) {
    const int tid = threadIdx.x, lane = tid & 63, wid = __builtin_amdgcn_readfirstlane(tid >> 6);
    const bf16_t* PROJ = (const bf16_t*)(a.ws + WS_PROJ);
    const bf16_t* W2t = (const bf16_t*)(a.ws + WS_W2T); const bf16_t* A2t = (const bf16_t*)(a.ws + WS_A2T); const bf16_t* G2t = (const bf16_t*)(a.ws + WS_G2T);
    constexpr int XP = 264;
    LAS bf16_t* Xs = (LAS bf16_t*)(lds + wid * 8448);
    LAS unsigned char* AIMG = lds + 67584 + wid * 3072;
    LAS float* ATL = (LAS float*)(AIMG + 2048);
    const int fr = lane & 15, fq = lane >> 4;
    LAS float* CT = (LAS float*)(lds + 92160);
    { const int ch = tid;
      CT[ch] = a.in[I_MUR][ch]; CT[512 + ch] = a.in[I_MUK][ch]; CT[1024 + ch] = a.in[I_MUV][ch]; CT[1536 + ch] = a.in[I_W0][ch];
      CT[2048 + ch] = a.in[I_A0][ch]; CT[2560 + ch] = a.in[I_KK][ch]; CT[3072 + ch] = a.in[I_KA][ch]; CT[3584 + ch] = a.in[I_RK][ch]; }
    LAS unsigned char* WB = lds + 108544;
    const unsigned char* wsrc[4];
#pragma unroll
    for (int q = 0; q < 4; ++q) { const int pz = wid * 4 + q;
        if (pz < 16) { const int row = 8 * (pz & 7) + (lane >> 3), pc = lane & 7, lc = pc ^ ((row >> 1) & 7);
            wsrc[q] = (const unsigned char*)((pz < 8) ? W2t : A2t) + row * 128 + lc * 16; }
        else { const int row = 4 * (pz - 16) + (lane >> 4), pc = lane & 15, lc = pc ^ (row & 15);
            wsrc[q] = (const unsigned char*)G2t + row * 256 + lc * 16; } }
    const int whs = (wid < 4) ? 8192 : 16384;
#define P3_WDMA(hd_) do { _Pragma("unroll") for (int q_ = 0; q_ < 4; ++q_) \
        __builtin_amdgcn_global_load_lds((const unsigned*)(wsrc[q_] + (size_t)(hd_) * whs), (LAS unsigned*)(WB + (wid * 4 + q_) * 1024), 16, 0, 0); } while (0)
    __syncthreads();
    for (int tt = blockIdx.x * NWAVES + wid; tt < TOK / 16; tt += gridDim.x * NWAVES) {
        const int t0 = tt * 16;
        P3_WDMA(0);
        {
            const int xtok = lane >> 2, xp = lane & 3; const int tx = t0 + xtok; const bool hp = (tx % SEQ) != 0;
            const bf16_t* rc = PROJ + (size_t)tx * NPROJ; const bf16_t* rp = PROJ + (size_t)(tx - (hp ? 1 : 0)) * NPROJ;
#pragma unroll
            for (int jb = 0; jb < 2; ++jb) {
                u32x4 cw4[4], pw4[4];
#pragma unroll
                for (int jj = 0; jj < 4; ++jj) { const int j = 4 * jb + jj, j8 = (xp + 4 * j) * 8;
                    const int ccur = (j < 2) ? 3072 + j8 : (j < 4) ? 3200 + (j8 - 64) : 3328 + (j8 - 128), cprev = (j < 2) ? 3136 + j8 : (j < 4) ? 3264 + (j8 - 64) : 3456 + (j8 - 128);
                    cw4[jj] = *(const u32x4*)(rc + ccur); pw4[jj] = *(const u32x4*)(rp + cprev); if (!hp) pw4[jj] = (u32x4){0u, 0u, 0u, 0u}; }
#pragma unroll
                for (int jj = 0; jj < 4; ++jj) { const int j = 4 * jb + jj, j8 = (xp + 4 * j) * 8; unsigned o[4];
#pragma unroll
                    for (int i = 0; i < 4; ++i) { float lo = bflo(cw4[jj][i]) + bflo(pw4[jj][i]), hi = bfhi(cw4[jj][i]) + bfhi(pw4[jj][i]);
                        if (j < 2) { lo = tanh_f(lo); hi = tanh_f(hi); } else if (j >= 4) { lo = sigm_f(lo); hi = sigm_f(hi); }
                        o[i] = pk2(lo, hi); }
                    *(LAS u32x4*)(Xs + xtok * XP + j8) = (u32x4){o[0], o[1], o[2], o[3]}; }
            }
        }
        LDS_WAIT(); asm volatile("" ::: "memory");
        const int t = t0 + fr; const bool has_prev = (t % SEQ) != 0;
        const int bb = t0 / SEQ, cc = (t0 % SEQ) / 16;
        const bf16_t* prow = PROJ + (size_t)t * NPROJ; const bf16_t* pprev = PROJ + (size_t)(t - (has_prev ? 1 : 0)) * NPROJ;
#pragma unroll 1
        for (int hd = 0; hd < 8; ++hd) {
        if (hd == 0) asm volatile("s_waitcnt vmcnt(0)\n\ts_barrier" ::: "memory"); else asm volatile("s_waitcnt vmcnt(8)\n\ts_barrier" ::: "memory");
        unsigned char* ops = a.ws + WS_OPS + (size_t)((bb * 8 + hd) * 256 + cc) * OPS_STRIDE;
        if (a.flags & 4) ops = (unsigned char*)a.out + (size_t)(blockIdx.x * 8 + wid) * OPS_STRIDE;
        u32x2 prc[4], pkc[4], pvc[4], prp[4], pkp[4], pvp[4];
#pragma unroll
        for (int i = 0; i < 4; ++i) { const int ch = 64 * hd + 16 * i + 4 * fq;
            prc[i] = *(const u32x2*)(prow + 1536 + ch); pkc[i] = *(const u32x2*)(prow + 2048 + ch); pvc[i] = *(const u32x2*)(prow + 2560 + ch);
            prp[i] = *(const u32x2*)(pprev + 1536 + ch); pkp[i] = *(const u32x2*)(pprev + 2048 + ch); pvp[i] = *(const u32x2*)(pprev + 2560 + ch);
            if (!has_prev) { prp[i] = (u32x2){0u, 0u}; pkp[i] = prp[i]; pvp[i] = prp[i]; } }
        f32x4 lw[4], la[4];
        {   bf16x8 bx[8];
#pragma unroll
            for (int ks = 0; ks < 8; ++ks) bx[ks] = *(const LAS bf16x8*)(Xs + fr * XP + ks * 32 + fq * 8);
#pragma unroll
            for (int i = 0; i < 4; ++i) {
                f32x4 cw = (f32x4){0.f, 0.f, 0.f, 0.f}, ca = cw, cg_ = cw;
#pragma unroll
                for (int ks = 0; ks < 2; ++ks) { const bf16x8 af = *(const LAS bf16x8*)(WB + (16 * i + fr) * 128 + (((ks * 4 + fq) ^ ((fr >> 1) & 7)) * 16)); cw = __builtin_amdgcn_mfma_f32_16x16x32_bf16(af, bx[ks], cw, 0, 0, 0); }
#pragma unroll
                for (int ks = 0; ks < 2; ++ks) { const bf16x8 af = *(const LAS bf16x8*)(WB + 8192 + (16 * i + fr) * 128 + (((ks * 4 + fq) ^ ((fr >> 1) & 7)) * 16)); ca = __builtin_amdgcn_mfma_f32_16x16x32_bf16(af, bx[2 + ks], ca, 0, 0, 0); }
#pragma unroll
                for (int ks = 0; ks < 4; ++ks) { const bf16x8 af = *(const LAS bf16x8*)(WB + 16384 + (16 * i + fr) * 256 + (((ks * 4 + fq) ^ fr) * 16)); cg_ = __builtin_amdgcn_mfma_f32_16x16x32_bf16(af, bx[4 + ks], cg_, 0, 0, 0); }
                lw[i] = cw; la[i] = ca;
                *(u32x2*)(ops + OP_G + (fr * 64 + 16 * i + 4 * fq) * 2) = (u32x2){pk2(cg_[0], cg_[1]), pk2(cg_[2], cg_[3])};
                asm volatile("" ::: "memory");
            }
        }
        float ssq = 0.f;
#pragma unroll
        for (int i = 0; i < 4; ++i) { const int ch = 64 * hd + 16 * i + 4 * fq;
            const f32x4 muk = *(const LAS f32x4*)(CT + 512 + ch), k_k = *(const LAS f32x4*)(CT + 2560 + ch);
#pragma unroll
            for (int e = 0; e < 4; ++e) { const float pk = (e & 1) ? bfhi(pkc[i][e >> 1]) : bflo(pkc[i][e >> 1]), pkv = (e & 1) ? bfhi(pkp[i][e >> 1]) : bflo(pkp[i][e >> 1]);
                const float kkr = (pk + (pkv - pk) * muk[e]) * k_k[e]; ssq += kkr * kkr; } }
        ssq += __shfl_xor(ssq, 16); ssq += __shfl_xor(ssq, 32);
        const float inv = 1.f / fmaxf(sqrtf(ssq), 1e-12f);
#pragma unroll
        for (int i = 0; i < 4; ++i) asm volatile("" :: "v"(prc[i]), "v"(pkc[i]), "v"(pvc[i]), "v"(prp[i]), "v"(pkp[i]), "v"(pvp[i]));
        asm volatile("s_waitcnt lgkmcnt(0)\n\ts_barrier" ::: "memory");
        if (hd < 7) P3_WDMA(hd + 1);
        f32x4 aab = (f32x4){0.f, 0.f, 0.f, 0.f}, aak = aab, arb = aab, ark = aab; float bon = 0.f;
#pragma unroll 1
        for (int s = 0; s < 2; ++s) {
            float r8[8], km8[8], kk8[8], b8[8], ld8[8];
#pragma unroll
            for (int ii = 0; ii < 2; ++ii) {
                const int i = 2 * s + ii;
                const f32x4 cw = lw[ii], ca = la[ii];
                const int chl = 16 * i + 4 * fq, ch = 64 * hd + chl;
                const f32x4 mur = *(const LAS f32x4*)(CT + ch), muk = *(const LAS f32x4*)(CT + 512 + ch), muv = *(const LAS f32x4*)(CT + 1024 + ch), w0 = *(const LAS f32x4*)(CT + 1536 + ch), a0 = *(const LAS f32x4*)(CT + 2048 + ch);
                const f32x4 k_k = *(const LAS f32x4*)(CT + 2560 + ch), k_a = *(const LAS f32x4*)(CT + 3072 + ch), r_k = *(const LAS f32x4*)(CT + 3584 + ch);
                float vv[4];
#pragma unroll
                for (int e = 0; e < 4; ++e) {
                    const float pr = (e & 1) ? bfhi(prc[ii][e >> 1]) : bflo(prc[ii][e >> 1]), prv = (e & 1) ? bfhi(prp[ii][e >> 1]) : bflo(prp[ii][e >> 1]);
                    const float pk = (e & 1) ? bfhi(pkc[ii][e >> 1]) : bflo(pkc[ii][e >> 1]), pkv = (e & 1) ? bfhi(pkp[ii][e >> 1]) : bflo(pkp[ii][e >> 1]);
                    const float pv = (e & 1) ? bfhi(pvc[ii][e >> 1]) : bflo(pvc[ii][e >> 1]), pvv = (e & 1) ? bfhi(pvp[ii][e >> 1]) : bflo(pvp[ii][e >> 1]);
                    const float r = pr + (prv - pr) * mur[e], k = pk + (pkv - pk) * muk[e]; vv[e] = pv + (pvv - pv) * muv[e];
                    const float z = w0[e] + cw[e];
                    const float sp = fmaxf(-z, 0.f) + __logf(1.f + __expf(-fabsf(z)));
                    const float wlog = -sp - 0.5f;
                    const float iclr = sigm_f(a0[e] + ca[e]);
                    const float kkn = k * k_k[e] * inv, km = k * (1.f + (iclr - 1.f) * k_a[e]);
                    r8[4 * ii + e] = r; km8[4 * ii + e] = km; kk8[4 * ii + e] = kkn; b8[4 * ii + e] = kkn * iclr; ld8[4 * ii + e] = -__expf(wlog);
                    bon += r * km * r_k[e];
                }
                *(u32x2*)(ops + OP_V + (fr * 64 + chl) * 2) = (u32x2){pk2(vv[0], vv[1]), pk2(vv[2], vv[3])};
            }
            float rt[8], at[8], bt[8], kt[8], bh[8], kh[8], gcv[8];
#pragma unroll
            for (int j = 0; j < 8; ++j) {
                const float cum = prefix16(ld8[j]); const float tot = __shfl(cum, (lane & 48) | 15);
                const float e1 = __expf(cum), e2 = __expf(-cum), e3 = __expf(cum - ld8[j]), e4 = __expf(tot - cum);
                rt[j] = r8[j] * e1; at[j] = -kk8[j] * e3; bt[j] = b8[j] * e2; kt[j] = km8[j] * e2; bh[j] = b8[j] * e4; kh[j] = km8[j] * e4; gcv[j] = e1;
            }
            const bf16x8 RT = pack8(rt), AT = pack8(at), BT = pack8(bt), KT = pack8(kt);
            *(bf16x8*)(ops + OP_RP + ((s * 16 + fr) * 4 + fq) * 16) = RT;
#pragma unroll
            for (int ii = 0; ii < 2; ++ii) { const int chl = 16 * (2 * s + ii) + 4 * fq;
                *(LAS u32x2*)(AIMG + (fr * 64 + chl) * 2) = (u32x2){pk2(at[4 * ii], at[4 * ii + 1]), pk2(at[4 * ii + 2], at[4 * ii + 3])};
                *(u32x2*)(ops + OP_BH + (fr * 64 + chl) * 2) = (u32x2){pk2(bh[4 * ii], bh[4 * ii + 1]), pk2(bh[4 * ii + 2], bh[4 * ii + 3])};
                *(u32x2*)(ops + OP_KH + (fr * 64 + chl) * 2) = (u32x2){pk2(kh[4 * ii], kh[4 * ii + 1]), pk2(kh[4 * ii + 2], kh[4 * ii + 3])};
                if (fr == 15) *(f32x4*)(ops + OP_GC + chl * 4) = (f32x4){gcv[4 * ii], gcv[4 * ii + 1], gcv[4 * ii + 2], gcv[4 * ii + 3]}; }
            aab = __builtin_amdgcn_mfma_f32_16x16x32_bf16(AT, BT, aab, 0, 0, 0); aak = __builtin_amdgcn_mfma_f32_16x16x32_bf16(AT, KT, aak, 0, 0, 0);
            arb = __builtin_amdgcn_mfma_f32_16x16x32_bf16(RT, BT, arb, 0, 0, 0); ark = __builtin_amdgcn_mfma_f32_16x16x32_bf16(RT, KT, ark, 0, 0, 0);
#pragma unroll
            for (int ii = 0; ii < 2; ++ii) { lw[ii] = lw[2 + ii]; la[ii] = la[2 + ii]; prc[ii] = prc[2 + ii]; pkc[ii] = pkc[2 + ii]; pvc[ii] = pvc[2 + ii]; prp[ii] = prp[2 + ii]; pkp[ii] = pkp[2 + ii]; pvp[ii] = pvp[2 + ii]; }
        }
        bon += __shfl_xor(bon, 16); bon += __shfl_xor(bon, 32);
        if (fq == 0) *(float*)(ops + OP_BON + fr * 4) = bon;
#pragma unroll
        for (int e = 0; e < 4; ++e) { const int tq = 4 * fq + e; if (!(fr < tq)) { aab[e] = 0.f; aak[e] = 0.f; } if (!(fr <= tq)) { arb[e] = 0.f; ark[e] = 0.f; } }
        *(u32x2*)(ops + OP_ARBT + (fr * 16 + 4 * fq) * 2) = (u32x2){pk2(arb[0], arb[1]), pk2(arb[2], arb[3])};
        *(u32x2*)(ops + OP_ARKT + (fr * 16 + 4 * fq) * 2) = (u32x2){pk2(ark[0], ark[1]), pk2(ark[2], ark[3])};
        *(LAS f32x4*)(ATL + fr * 16 + 4 * fq) = aab;
        LDS_WAIT(); asm volatile("" ::: "memory");
        float x[16];
#pragma unroll
        for (int m = 0; m < 16; ++m) x[m] = (m == fr) ? 1.f : 0.f;
#pragma unroll
        for (int j = 14; j >= 0; --j) {
            float acc = x[j];
#pragma unroll
            for (int mq = (j + 1) / 4; mq < 4; ++mq) { const f32x4 col = *(const LAS f32x4*)(ATL + j * 16 + 4 * mq);
#pragma unroll
                for (int e = 0; e < 4; ++e) { const int m = 4 * mq + e; if (m > j) acc += x[m] * col[e]; } }
            x[j] = acc;
        }
        float xs[4];
#pragma unroll
        for (int e = 0; e < 4; ++e) xs[e] = (fq == 0) ? x[e] : (fq == 1) ? x[4 + e] : (fq == 2) ? x[8 + e] : x[12 + e];
        const bf16x8 xa = pack4z(xs[0], xs[1], xs[2], xs[3]);
        {   const f32x4 z4 = __builtin_amdgcn_mfma_f32_16x16x32_bf16(xa, pack4z(aak[0], aak[1], aak[2], aak[3]), (f32x4){0.f, 0.f, 0.f, 0.f}, 0, 0, 0);
            *(u32x2*)(ops + OP_ZT + (fr * 16 + 4 * fq) * 2) = (u32x2){pk2(z4[0], z4[1]), pk2(z4[2], z4[3])}; }
#pragma unroll
        for (int kt = 0; kt < 4; ++kt) {
            const s16x4 tr = vtr(AIMG + ((4 * fq + (fr >> 2)) * 64 + 16 * kt + 4 * (fr & 3)) * 2);
            const bf16x8 bw = (bf16x8){tr[0], tr[1], tr[2], tr[3], 0, 0, 0, 0};
            const f32x4 w4 = __builtin_amdgcn_mfma_f32_16x16x32_bf16(xa, bw, (f32x4){0.f, 0.f, 0.f, 0.f}, 0, 0, 0);
            *(u32x2*)(ops + OP_WT + ((16 * kt + fr) * 16 + 4 * fq) * 2) = (u32x2){pk2(w4[0], w4[1]), pk2(w4[2], w4[3])};
        }
        LDS_WAIT(); asm volatile("" ::: "memory");
        }
    }
}

constexpr int SC_NS = 9, SC_D = 7, SC_YB = SC_NS * OPS_STRIDE;
__device__ __forceinline__ void scan_unit(const Args& a, LAS unsigned char* lds, int bh) {
    const int tid = threadIdx.x, lane = tid & 63; const int wid = __builtin_amdgcn_readfirstlane(tid >> 6);
    const int b = bh >> 3, h = bh & 7;
    const unsigned char* ops_base = a.ws + WS_OPS + (size_t)bh * 256 * OPS_STRIDE;
    bf16_t* YIN = (bf16_t*)((unsigned char*)a.out + 64 * MiB);
    constexpr int NCH = SEQ / 16;
    asm volatile("s_waitcnt vmcnt(0) lgkmcnt(0)\n\ts_barrier" ::: "memory");
    if (wid == 4 || wid == 5) {
        const int pw = (wid - 4) * 7;
#define SC_ISSUE(c) do { const unsigned char* g_ = ops_base + (size_t)(c) * OPS_STRIDE + (pw * 1024) + lane * 16; const int so_ = ((c) % SC_NS) * OPS_STRIDE + pw * 1024; \
        _Pragma("unroll") for (int p_ = 0; p_ < 7; ++p_) __builtin_amdgcn_global_load_lds((const unsigned*)(g_ + p_ * 1024), (LAS unsigned*)(lds + so_ + p_ * 1024), 16, 0, 0); } while (0)
        for (int c = 0; c < SC_D; ++c) SC_ISSUE(c);
        for (int c = 0; c < NCH; ++c) {
            if (c <= NCH - SC_D) asm volatile("s_waitcnt vmcnt(35)\n\ts_barrier" ::: "memory"); else asm volatile("s_waitcnt vmcnt(0)\n\ts_barrier" ::: "memory");
            if (c + SC_D < NCH) SC_ISSUE(c + SC_D);
        }
        asm volatile("s_waitcnt vmcnt(0)\n\ts_barrier" ::: "memory");
        asm volatile("s_barrier" ::: "memory");
#undef SC_ISSUE
    } else if (wid < 4) {
        const int vl = lane & 15, g = lane >> 4, i4 = (lane & 15) >> 2, p4 = lane & 3;
        f32x4 st[4];
#pragma unroll
        for (int kt = 0; kt < 4; ++kt) st[kt] = (f32x4){0.f, 0.f, 0.f, 0.f};
        const int trw = ((4 * g + i4) * 16 + 4 * p4) * 2;
        const int trk = ((4 * g + i4) * 64 + 4 * p4) * 2;
#define SC_FDECL(X) bf16x8 X##wa0, X##wa1, X##rp0, X##rp1; s16x4 X##zt, X##vt, X##ab, X##ak, X##bh0, X##bh1, X##bh2, X##bh3, X##kh0, X##kh1, X##kh2, X##kh3; f32x4 X##gc0, X##gc1, X##gc2, X##gc3
#define SC_FLOAD(X, c_) do { const LAS unsigned char* sl_ = lds + ((c_) % SC_NS) * OPS_STRIDE; \
        { const s16x4 a_ = vtr(sl_ + OP_WT + trw), b_ = vtr(sl_ + OP_WT + 16 * 32 + trw); X##wa0 = (bf16x8){a_[0], a_[1], a_[2], a_[3], b_[0], b_[1], b_[2], b_[3]}; } \
        { const s16x4 a_ = vtr(sl_ + OP_WT + 32 * 32 + trw), b_ = vtr(sl_ + OP_WT + 48 * 32 + trw); X##wa1 = (bf16x8){a_[0], a_[1], a_[2], a_[3], b_[0], b_[1], b_[2], b_[3]}; } \
        X##rp0 = *(const LAS bf16x8*)(sl_ + OP_RP + ((0 * 16 + vl) * 4 + g) * 16); X##rp1 = *(const LAS bf16x8*)(sl_ + OP_RP + ((1 * 16 + vl) * 4 + g) * 16); \
        X##zt = vtr(sl_ + OP_ZT + trw); X##vt = vtr(sl_ + OP_V + trk + 32 * wid); X##ab = vtr(sl_ + OP_ARBT + trw); X##ak = vtr(sl_ + OP_ARKT + trw); \
        X##bh0 = vtr(sl_ + OP_BH + trk); X##bh1 = vtr(sl_ + OP_BH + trk + 32); X##bh2 = vtr(sl_ + OP_BH + trk + 64); X##bh3 = vtr(sl_ + OP_BH + trk + 96); \
        X##kh0 = vtr(sl_ + OP_KH + trk); X##kh1 = vtr(sl_ + OP_KH + trk + 32); X##kh2 = vtr(sl_ + OP_KH + trk + 64); X##kh3 = vtr(sl_ + OP_KH + trk + 96); \
        X##gc0 = *(const LAS f32x4*)(sl_ + OP_GC + (4 * g) * 4); X##gc1 = *(const LAS f32x4*)(sl_ + OP_GC + (16 + 4 * g) * 4); X##gc2 = *(const LAS f32x4*)(sl_ + OP_GC + (32 + 4 * g) * 4); X##gc3 = *(const LAS f32x4*)(sl_ + OP_GC + (48 + 4 * g) * 4); } while (0)
#define SC_STEP(X, c_) do { bf16x8 sb0_, sb1_; \
        { u32x4 w_ = (u32x4){pk2(st[0][0], st[0][1]), pk2(st[0][2], st[0][3]), pk2(st[1][0], st[1][1]), pk2(st[1][2], st[1][3])}; sb0_ = __builtin_bit_cast(bf16x8, w_); } \
        { u32x4 w_ = (u32x4){pk2(st[2][0], st[2][1]), pk2(st[2][2], st[2][3]), pk2(st[3][0], st[3][1]), pk2(st[3][2], st[3][3])}; sb1_ = __builtin_bit_cast(bf16x8, w_); } \
        f32x4 u_ = (f32x4){0.f, 0.f, 0.f, 0.f}, y_ = u_; \
        u_ = __builtin_amdgcn_mfma_f32_16x16x32_bf16(X##wa0, sb0_, u_, 0, 0, 0); u_ = __builtin_amdgcn_mfma_f32_16x16x32_bf16(X##wa1, sb1_, u_, 0, 0, 0); \
        u_ = __builtin_amdgcn_mfma_f32_16x16x32_bf16((bf16x8){X##zt[0], X##zt[1], X##zt[2], X##zt[3], 0, 0, 0, 0}, (bf16x8){X##vt[0], X##vt[1], X##vt[2], X##vt[3], 0, 0, 0, 0}, u_, 0, 0, 0); \
        y_ = __builtin_amdgcn_mfma_f32_16x16x32_bf16(X##rp0, sb0_, y_, 0, 0, 0); y_ = __builtin_amdgcn_mfma_f32_16x16x32_bf16(X##rp1, sb1_, y_, 0, 0, 0); \
        bf16x8 uv_; { u32x2 uw_ = (u32x2){pk2(u_[0], u_[1]), pk2(u_[2], u_[3])}; const s16x4 us_ = __builtin_bit_cast(s16x4, uw_); uv_ = (bf16x8){us_[0], us_[1], us_[2], us_[3], X##vt[0], X##vt[1], X##vt[2], X##vt[3]}; } \
        st[0] = __builtin_amdgcn_mfma_f32_16x16x32_bf16((bf16x8){X##bh0[0], X##bh0[1], X##bh0[2], X##bh0[3], X##kh0[0], X##kh0[1], X##kh0[2], X##kh0[3]}, uv_, st[0] * X##gc0, 0, 0, 0); \
        st[1] = __builtin_amdgcn_mfma_f32_16x16x32_bf16((bf16x8){X##bh1[0], X##bh1[1], X##bh1[2], X##bh1[3], X##kh1[0], X##kh1[1], X##kh1[2], X##kh1[3]}, uv_, st[1] * X##gc1, 0, 0, 0); \
        st[2] = __builtin_amdgcn_mfma_f32_16x16x32_bf16((bf16x8){X##bh2[0], X##bh2[1], X##bh2[2], X##bh2[3], X##kh2[0], X##kh2[1], X##kh2[2], X##kh2[3]}, uv_, st[2] * X##gc2, 0, 0, 0); \
        st[3] = __builtin_amdgcn_mfma_f32_16x16x32_bf16((bf16x8){X##bh3[0], X##bh3[1], X##bh3[2], X##bh3[3], X##kh3[0], X##kh3[1], X##kh3[2], X##kh3[3]}, uv_, st[3] * X##gc3, 0, 0, 0); \
        y_ = __builtin_amdgcn_mfma_f32_16x16x32_bf16((bf16x8){X##ab[0], X##ab[1], X##ab[2], X##ab[3], X##ak[0], X##ak[1], X##ak[2], X##ak[3]}, uv_, y_, 0, 0, 0); \
        LAS float* yb_ = (LAS float*)(lds + SC_YB + ((c_) & 1) * 4096) + 16 * wid + vl; \
        _Pragma("unroll") for (int e = 0; e < 4; ++e) yb_[(4 * g + e) * 64] = y_[e]; } while (0)
        SC_FDECL(fa_); SC_FDECL(fb_);
        for (int c = 0; c < NCH; c += 2) {
            asm volatile("s_waitcnt lgkmcnt(0)\n\ts_barrier" ::: "memory");
            if (c == 0) SC_FLOAD(fa_, 0);
            SC_FLOAD(fb_, c + 1);
            SC_STEP(fa_, c);
            asm volatile("s_waitcnt lgkmcnt(0)\n\ts_barrier" ::: "memory");
            if (c + 2 < NCH) SC_FLOAD(fa_, c + 2);
            SC_STEP(fb_, c + 1);
        }
#undef SC_FDECL
#undef SC_FLOAD
#undef SC_STEP
        asm volatile("s_waitcnt lgkmcnt(0)\n\ts_barrier" ::: "memory");
        asm volatile("s_barrier" ::: "memory");
    } else {
        const int pi = tid - 384, ptk = pi >> 3, pc8 = (pi & 7) * 8;
        const f32x4 lg0 = *(const f32x4*)(a.in[I_LNXG] + h * 64 + pc8), lg1 = *(const f32x4*)(a.in[I_LNXG] + h * 64 + pc8 + 4), lb0 = *(const f32x4*)(a.in[I_LNXB] + h * 64 + pc8), lb1 = *(const f32x4*)(a.in[I_LNXB] + h * 64 + pc8 + 4);
#define SC_POST(cc) do { const LAS unsigned char* sl_ = lds + ((cc) % SC_NS) * OPS_STRIDE; const LAS float* yb_ = (const LAS float*)(lds + SC_YB + ((cc) & 1) * 4096) + ptk * 64 + pc8; \
        const f32x4 y0_ = *(const LAS f32x4*)yb_, y1_ = *(const LAS f32x4*)(yb_ + 4); \
        const float mean_ = sum8(((y0_[0] + y0_[1]) + (y0_[2] + y0_[3])) + ((y1_[0] + y1_[1]) + (y1_[2] + y1_[3]))) * (1.f / 64.f); \
        const f32x4 d0_ = y0_ - mean_, d1_ = y1_ - mean_; \
        const float var_ = sum8(((d0_[0] * d0_[0] + d0_[1] * d0_[1]) + (d0_[2] * d0_[2] + d0_[3] * d0_[3])) + ((d1_[0] * d1_[0] + d1_[1] * d1_[1]) + (d1_[2] * d1_[2] + d1_[3] * d1_[3]))) * (1.f / 64.f); \
        const float rstd_ = 1.0f / sqrtf(var_ + LNX_EPS); \
        const u32x4 vw_ = *(const LAS u32x4*)(sl_ + OP_V + (ptk * 64 + pc8) * 2), gw_ = *(const LAS u32x4*)(sl_ + OP_G + (ptk * 64 + pc8) * 2); \
        const float bon_ = *(const LAS float*)(sl_ + OP_BON + ptk * 4); \
        const f32x4 v0_ = (f32x4){bflo(vw_[0]), bfhi(vw_[0]), bflo(vw_[1]), bfhi(vw_[1])}, v1_ = (f32x4){bflo(vw_[2]), bfhi(vw_[2]), bflo(vw_[3]), bfhi(vw_[3])}; \
        const f32x4 g0_ = (f32x4){bflo(gw_[0]), bfhi(gw_[0]), bflo(gw_[1]), bfhi(gw_[1])}, g1_ = (f32x4){bflo(gw_[2]), bfhi(gw_[2]), bflo(gw_[3]), bfhi(gw_[3])}; \
        const f32x4 o0_ = (d0_ * rstd_ * lg0 + lb0 + bon_ * v0_) * g0_, o1_ = (d1_ * rstd_ * lg1 + lb1 + bon_ * v1_) * g1_; \
        const size_t t_ = (size_t)b * SEQ + (size_t)(cc) * 16 + ptk; \
        *(u32x4*)(YIN + t_ * 1024 + 512 + h * 64 + pc8) = (u32x4){pk2(o0_[0], o0_[1]), pk2(o0_[2], o0_[3]), pk2(o1_[0], o1_[1]), pk2(o1_[2], o1_[3])}; } while (0)
        for (int c = 0; c < NCH; ++c) {
            asm volatile("s_waitcnt lgkmcnt(0)\n\ts_barrier" ::: "memory");
            if (c > 0) SC_POST(c - 1);
        }
        asm volatile("s_waitcnt lgkmcnt(0)\n\ts_barrier" ::: "memory");
        SC_POST(NCH - 1);
        asm volatile("s_waitcnt lgkmcnt(0)\n\ts_barrier" ::: "memory");
#undef SC_POST
    }
}

constexpr int AT_SLOT = 32768;
constexpr int AT_WSF = 4 * AT_SLOT;
constexpr int AT_XP = 132;
constexpr float AT_THR = 8.f;
#define MFMA16(A, B, C) __builtin_amdgcn_mfma_f32_16x16x32_bf16(A, B, C, 0, 0, 0)
__device__ __forceinline__ float max_over_rows(float m) {
    { auto r = __builtin_amdgcn_permlane16_swap(__float_as_uint(m), __float_as_uint(m), false, false); m = fmaxf(__uint_as_float(r[0]), __uint_as_float(r[1])); }
    { auto r = __builtin_amdgcn_permlane32_swap(__float_as_uint(m), __float_as_uint(m), false, false); m = fmaxf(__uint_as_float(r[0]), __uint_as_float(r[1])); }
    return m;
}
__device__ __forceinline__ void attn_unit(const Args& a, LAS unsigned char* lds, int b, int h, int u, float lam) {
    const int tid = threadIdx.x, lane = tid & 63, c16 = lane & 15, g = lane >> 4; const int wid = __builtin_amdgcn_readfirstlane(tid >> 6);
    const int comp = wid >> 2, wq = wid & 3;
    const bf16_t* PROJ = (const bf16_t*)(a.ws + WS_PROJ);
    bf16_t* YIN = (bf16_t*)((unsigned char*)a.out + 64 * MiB);
    const size_t rowbase = (size_t)b * SEQ; const int q0 = u * 128;
    const int NT = 2 * u + 2;
    const int ntw = (q0 + 32 * wq) / 64 + 1;
    LAS float* wsf = (LAS float*)(lds + AT_WSF) + wid * 64;
    const bf16_t* ksrc0 = PROJ + (rowbase + lane) * NPROJ + 512 + h * 128 + wid * 8;
    const bf16_t* vsrc0 = PROJ + (rowbase + 16 * (wid & 3) + (lane >> 2)) * NPROJ + 1024 + h * 128 + (wid >> 2) * 32 + (lane & 3) * 8;
#define AT_DMA(t) do { const size_t ro_ = (size_t)(t) * 64 * NPROJ; LAS unsigned char* S_ = lds + ((t) & 3) * AT_SLOT + wid * 1024; \
        __builtin_amdgcn_global_load_lds((const unsigned*)(ksrc0 + ro_), (LAS unsigned*)(S_), 16, 0, 0); \
        __builtin_amdgcn_global_load_lds((const unsigned*)(ksrc0 + ro_ + 64), (LAS unsigned*)(S_ + 8192), 16, 0, 0); \
        __builtin_amdgcn_global_load_lds((const unsigned*)(vsrc0 + ro_), (LAS unsigned*)(S_ + 16384), 16, 0, 0); \
        __builtin_amdgcn_global_load_lds((const unsigned*)(vsrc0 + ro_ + 64), (LAS unsigned*)(S_ + 16384 + 8192), 16, 0, 0); } while (0)
    asm volatile("s_waitcnt vmcnt(0) lgkmcnt(0)\n\ts_barrier" ::: "memory");
    const bf16_t* Qw = PROJ + (rowbase + q0 + 32 * wq + c16) * NPROJ + h * 128 + comp * 64 + 8 * g;
    bf16x8 qf[2][2];
#pragma unroll
    for (int rb = 0; rb < 2; ++rb)
#pragma unroll
        for (int s = 0; s < 2; ++s) qf[rb][s] = *(const bf16x8*)(Qw + (size_t)(16 * rb) * NPROJ + 32 * s);
    asm volatile("s_waitcnt vmcnt(0)" : "+v"(qf[0][0]), "+v"(qf[0][1]), "+v"(qf[1][0]), "+v"(qf[1][1]) :: "memory");
    AT_DMA(0);
    if (NT > 1) AT_DMA(1);
    if (NT > 2) AT_DMA(2);
    f32x4 o[2][8], lacc[2];
#pragma unroll
    for (int rb = 0; rb < 2; ++rb) { lacc[rb] = (f32x4){0.f, 0.f, 0.f, 0.f};
#pragma unroll
        for (int n = 0; n < 8; ++n) o[rb][n] = (f32x4){0.f, 0.f, 0.f, 0.f}; }
    float mhat[2] = {0.f, 0.f};
    const int qi0 = q0 + 32 * wq + c16;
    const int koff = comp * 8192 + g * 1024 + c16 * 16;
    const int voff = 16384 + (4 * g + (c16 >> 2)) * 64 + (c16 & 3) * 8;
    const bf16x8 ones = (bf16x8){0x3F80, 0x3F80, 0x3F80, 0x3F80, 0x3F80, 0x3F80, 0x3F80, 0x3F80};
    if (NT > 2) asm volatile("s_waitcnt vmcnt(8)\n\ts_barrier" ::: "memory"); else if (NT > 1) asm volatile("s_waitcnt vmcnt(4)\n\ts_barrier" ::: "memory"); else asm volatile("s_waitcnt vmcnt(0)\n\ts_barrier" ::: "memory");
    for (int t = 0; t < NT; ++t) {
        if (t + 3 < NT) AT_DMA(t + 3);
        if (t < ntw) {
            const LAS unsigned char* Kb = lds + (t & 3) * AT_SLOT + koff;
            const LAS unsigned char* Vb = lds + (t & 3) * AT_SLOT + voff;
            f32x4 st[2][4];
#pragma unroll
            for (int rb = 0; rb < 2; ++rb)
#pragma unroll
                for (int kt = 0; kt < 4; ++kt) st[rb][kt] = (f32x4){-mhat[rb], -mhat[rb], -mhat[rb], -mhat[rb]};
#pragma unroll
            for (int s = 0; s < 2; ++s)
#pragma unroll
                for (int kt = 0; kt < 4; ++kt) { const bf16x8 kf = *(const LAS bf16x8*)(Kb + s * 4096 + kt * 256);
                    st[0][kt] = MFMA16(kf, qf[0][s], st[0][kt]); st[1][kt] = MFMA16(kf, qf[1][s], st[1][kt]); }
            const int kv0 = t * 64;
            if (kv0 + 63 > q0 + 32 * wq) {
#pragma unroll
                for (int kt = 0; kt < 4; ++kt)
#pragma unroll
                    for (int e = 0; e < 4; ++e) { const int kv = kv0 + 16 * kt + 4 * g + e; if (kv > qi0) st[0][kt][e] = -INFINITY; if (kv > qi0 + 16) st[1][kt][e] = -INFINITY; }
            }
            float rm[2];
#pragma unroll
            for (int rb = 0; rb < 2; ++rb) { float m = fmaxf(fmaxf(st[rb][0][0], st[rb][0][1]), fmaxf(st[rb][0][2], st[rb][0][3]));
#pragma unroll
                for (int kt = 1; kt < 4; ++kt) m = fmaxf(fmaxf(m, st[rb][kt][0]), fmaxf(fmaxf(st[rb][kt][1], st[rb][kt][2]), st[rb][kt][3]));
                rm[rb] = max_over_rows(m); }
            if (t == 0 || __any(fmaxf(rm[0], rm[1]) > AT_THR)) {
#pragma unroll
                for (int rb = 0; rb < 2; ++rb) {
                    const float dl = (t == 0) ? rm[rb] : fmaxf(rm[rb], 0.f);
                    mhat[rb] += dl;
#pragma unroll
                    for (int kt = 0; kt < 4; ++kt) st[rb][kt] = st[rb][kt] - dl;
                    if (g == 0) wsf[16 * rb + c16] = __builtin_amdgcn_exp2f(-dl);
                }
                if (t != 0) {
                    LDS_WAIT();
#pragma unroll
                    for (int rb = 0; rb < 2; ++rb) { const f32x4 f4 = *(const LAS f32x4*)(wsf + 16 * rb + 4 * g);
                        lacc[rb] = lacc[rb] * f4;
#pragma unroll
                        for (int n = 0; n < 8; ++n) o[rb][n] = o[rb][n] * f4; }
                }
                LDS_WAIT();
            }
            bf16x8 pa[2][2];
#pragma unroll
            for (int rb = 0; rb < 2; ++rb) {
#pragma unroll
                for (int kt = 0; kt < 4; ++kt)
#pragma unroll
                    for (int e = 0; e < 4; ++e) st[rb][kt][e] = __builtin_amdgcn_exp2f(st[rb][kt][e]);
#pragma unroll
                for (int sp = 0; sp < 2; ++sp) { const f32x4 x0 = st[rb][2 * sp], x1 = st[rb][2 * sp + 1];
                    u32x4 w = (u32x4){pk2(x0[0], x0[1]), pk2(x0[2], x0[3]), pk2(x1[0], x1[1]), pk2(x1[2], x1[3])}; pa[rb][sp] = __builtin_bit_cast(bf16x8, w); }
            }
#pragma unroll
            for (int rb = 0; rb < 2; ++rb)
#pragma unroll
                for (int sp = 0; sp < 2; ++sp) lacc[rb] = MFMA16(pa[rb][sp], ones, lacc[rb]);
#pragma unroll
            for (int n = 0; n < 8; ++n)
#pragma unroll
                for (int sp = 0; sp < 2; ++sp) {
                    const LAS unsigned char* vp = Vb + (n >> 1) * 4096 + (n & 1) * 32 + sp * 2048;
                    const s16x4 lo = vtr(vp), hv = vtr(vp + 1024);
                    const bf16x8 vf = (bf16x8){lo[0], lo[1], lo[2], lo[3], hv[0], hv[1], hv[2], hv[3]};
                    o[0][n] = MFMA16(pa[0][sp], vf, o[0][n]); o[1][n] = MFMA16(pa[1][sp], vf, o[1][n]);
                }
        }
        if (t + 3 < NT) asm volatile("s_waitcnt vmcnt(8) lgkmcnt(0)\n\ts_barrier" ::: "memory");
        else if (t + 2 < NT) asm volatile("s_waitcnt vmcnt(4) lgkmcnt(0)\n\ts_barrier" ::: "memory");
        else asm volatile("s_waitcnt vmcnt(0) lgkmcnt(0)\n\ts_barrier" ::: "memory");
    }
    LAS float* Xt = (LAS float*)lds + wq * (32 * AT_XP);
    if (comp == 1) {
#pragma unroll
        for (int rb = 0; rb < 2; ++rb)
#pragma unroll
            for (int e = 0; e < 4; ++e) { const float rl = 1.0f / lacc[rb][e];
#pragma unroll
                for (int n = 0; n < 8; ++n) Xt[(16 * rb + 4 * g + e) * AT_XP + 16 * n + c16] = o[rb][n][e] * rl; }
    }
    __syncthreads();
    if (comp == 0) {
#pragma unroll
        for (int rb = 0; rb < 2; ++rb)
#pragma unroll
            for (int e = 0; e < 4; ++e) { const float rl = 1.0f / lacc[rb][e];
#pragma unroll
                for (int n = 0; n < 8; ++n) { LAS float* p = Xt + (16 * rb + 4 * g + e) * AT_XP + 16 * n + c16; *p = o[rb][n][e] * rl - lam * (*p); } }
        LDS_WAIT(); asm volatile("" ::: "memory");
        const int row = lane >> 1, half = lane & 1;
        const LAS float* rp = Xt + row * AT_XP + half * 64;
        f32x4 v[16]; float ss = 0.f;
#pragma unroll
        for (int i = 0; i < 16; ++i) { v[i] = *(const LAS f32x4*)(rp + 4 * i); ss += (v[i][0] * v[i][0] + v[i][1] * v[i][1]) + (v[i][2] * v[i][2] + v[i][3] * v[i][3]); }
        ss += __shfl_xor(ss, 1);
        const float rstd = 0.8f / sqrtf(ss * (1.f / 128.f) + SUBLN_EPS);
        const float* sg = a.in[I_SUBLN] + half * 64;
        bf16_t* op = YIN + (rowbase + q0 + 32 * wq + row) * 1024 + h * 128 + half * 64;
#pragma unroll
        for (int i = 0; i < 8; ++i) { const f32x4 g0 = *(const f32x4*)(sg + 8 * i), g1 = *(const f32x4*)(sg + 8 * i + 4); const f32x4 x0 = v[2 * i] * rstd * g0, x1 = v[2 * i + 1] * rstd * g1;
            *(u32x4*)(op + 8 * i) = (u32x4){pk2(x0[0], x0[1]), pk2(x0[2], x0[3]), pk2(x1[0], x1[1]), pk2(x1[2], x1[3])}; }
    }
    __syncthreads();
#undef AT_DMA
}
#undef MFMA16

__device__ __forceinline__ void phase4(const Args& a, LAS unsigned char* lds) {
    const int tid = threadIdx.x;
    if (!(a.flags & 1)) for (int bh = blockIdx.x; bh < 64; bh += gridDim.x) scan_unit(a, lds, bh);
    if (a.flags & 2) return;
    float lam;
    { const int l = tid & 63; const float s1 = wave_sum(a.in[I_LQ1][l] * a.in[I_LK1][l]), s2 = wave_sum(a.in[I_LQ2][l] * a.in[I_LK2][l]); lam = __expf(s1) - __expf(s2) + 0.2f; }
    unsigned* ctl = (unsigned*)(a.ws + WS_CTL);
    LAS unsigned* qslot = (LAS unsigned*)(lds + 147456 - 64);
    for (;;) {
        __syncthreads();
        if (tid == 0) *qslot = atomicAdd(ctl + CW_QUEUE, 1u);
        __syncthreads();
        const unsigned idx = *qslot;
        if (idx >= 1024u) break;
        const int u = 31 - (int)(idx >> 5), bh = (int)(idx & 31);
        attn_unit(a, lds, bh >> 2, bh & 3, u, lam);
    }
}

__device__ __forceinline__ void phase6(const Args& a, LAS unsigned char* lds) {
    const int tid = threadIdx.x, lane = tid & 63, wid = __builtin_amdgcn_readfirstlane(tid >> 6);
    LAS float* cG = (LAS float*)lds; LAS float* cA = cG + 1024; LAS float* cB = cA + 1024;
    const bf16_t* YM = (const bf16_t*)(a.ws + WS_YMIX); const float* SSQ = (const float*)(a.ws + WS_SSQ1);
    bf16_t* H2 = (bf16_t*)(a.ws + WS_H2);
    for (int rb = blockIdx.x; rb < TOK / 128; rb += gridDim.x) {
        const int b = rb / 32;
        __syncthreads();
        for (int j = tid; j < 1024; j += NTHREADS) { cG[j] = ada_val(a, b, 2048 + j) * a.in[I_GPOSTMIX][j]; cA[j] = a.in[I_GPREFFN][j] * (1.f + ada_val(a, b, 4096 + j)); cB[j] = ada_val(a, b, 3072 + j); }
        __syncthreads();
        for (int rr = wid; rr < 128; rr += 2 * NWAVES) {
            const size_t row0 = (size_t)rb * 128 + rr;
            f32x4 xv[2][4]; u32x2 yv[2][4]; float sq[2];
#pragma unroll
            for (int q = 0; q < 2; ++q) { const size_t row = row0 + q * NWAVES; sq[q] = (lane < 16) ? SSQ[row * 16 + lane] : 0.f;
                const f32x4* xr = (const f32x4*)(a.in[I_X] + row * DM) + lane; const u32x2* yr = (const u32x2*)(YM + row * DM) + lane;
#pragma unroll
                for (int j = 0; j < 4; ++j) { xv[q][j] = __builtin_nontemporal_load(xr + 64 * j); yv[q][j] = __builtin_nontemporal_load(yr + 64 * j); } }
#pragma unroll
            for (int q = 0; q < 2; ++q) { const size_t row = row0 + q * NWAVES;
                const float rstd0 = 1.0f / sqrtf(wave_sum(sq[q]) * (1.f / DM) + RMS_EPS);
                f32x4 v[4]; float s = 0.f;
#pragma unroll
                for (int j = 0; j < 4; ++j) { const u32x2 yw = yv[q][j]; const f32x4 y = (f32x4){bflo(yw[0]), bfhi(yw[0]), bflo(yw[1]), bfhi(yw[1])};
                    const f32x4 g = *(const LAS f32x4*)(cG + 4 * lane + 256 * j);
                    v[j] = xv[q][j] + g * y * rstd0; s += (v[j].x * v[j].x + v[j].y * v[j].y) + (v[j].z * v[j].z + v[j].w * v[j].w); }
                const float rstd = 1.0f / sqrtf(wave_sum(s) * (1.f / DM) + RMS_EPS);
                unsigned long long* o8 = (unsigned long long*)(H2 + row * DM) + lane;
#pragma unroll
                for (int j = 0; j < 4; ++j) {
                    const f32x4 ca = *(const LAS f32x4*)(cA + 4 * lane + 256 * j), cb = *(const LAS f32x4*)(cB + 4 * lane + 256 * j);
                    const f32x4 hh = v[j] * rstd * ca + cb;
                    o8[64 * j] = (unsigned long long)pk2(hh.x, hh.y) | ((unsigned long long)pk2(hh.z, hh.w) << 32); }
            }
        }
    }
}
__device__ __forceinline__ void phase9(const Args& a, LAS unsigned char* lds) {
    const int tid = threadIdx.x, lane = tid & 63, wid = __builtin_amdgcn_readfirstlane(tid >> 6);
    LAS float* cG = (LAS float*)lds; LAS float* cM = cG + 1024;
    const bf16_t* FF = (const bf16_t*)(a.ws + WS_F); const float* SSQ = (const float*)(a.ws + WS_SSQ2);
    const bf16_t* YM = (const bf16_t*)(a.ws + WS_YMIX); const float* SSQ1 = (const float*)(a.ws + WS_SSQ1);
    for (int rb = blockIdx.x; rb < TOK / 128; rb += gridDim.x) {
        const int b = rb / 32;
        __syncthreads();
        for (int j = tid; j < 1024; j += NTHREADS) { cG[j] = ada_val(a, b, 5120 + j) * a.in[I_GPOSTFFN][j]; cM[j] = ada_val(a, b, 2048 + j) * a.in[I_GPOSTMIX][j]; }
        __syncthreads();
        for (int rr = wid; rr < 128; rr += 2 * NWAVES) {
            const size_t row0 = (size_t)rb * 128 + rr;
            f32x4 xv[2][4]; u32x2 yv[2][4], mv[2][4]; float sq[2], sm[2];
#pragma unroll
            for (int q = 0; q < 2; ++q) { const size_t row = row0 + q * NWAVES; sq[q] = (lane < 16) ? SSQ[row * 16 + lane] : 0.f; sm[q] = (lane < 16) ? SSQ1[row * 16 + lane] : 0.f;
                const f32x4* xr = (const f32x4*)(a.in[I_X] + row * DM) + lane; const u32x2* yr = (const u32x2*)(FF + row * DM) + lane; const u32x2* mr = (const u32x2*)(YM + row * DM) + lane;
#pragma unroll
                for (int j = 0; j < 4; ++j) { xv[q][j] = __builtin_nontemporal_load(xr + 64 * j); yv[q][j] = __builtin_nontemporal_load(yr + 64 * j); mv[q][j] = __builtin_nontemporal_load(mr + 64 * j); } }
#pragma unroll
            for (int q = 0; q < 2; ++q) { const size_t row = row0 + q * NWAVES;
                const float rstd0 = 1.0f / sqrtf(wave_sum(sq[q]) * (1.f / DM) + RMS_EPS), rstdm = 1.0f / sqrtf(wave_sum(sm[q]) * (1.f / DM) + RMS_EPS);
                f32x4* orow = (f32x4*)(a.out + row * DM) + lane;
#pragma unroll
                for (int j = 0; j < 4; ++j) { const u32x2 yw = yv[q][j], mw = mv[q][j];
                    const f32x4 y = (f32x4){bflo(yw[0]), bfhi(yw[0]), bflo(yw[1]), bfhi(yw[1])}, m = (f32x4){bflo(mw[0]), bfhi(mw[0]), bflo(mw[1]), bfhi(mw[1])};
                    const f32x4 g = *(const LAS f32x4*)(cG + 4 * lane + 256 * j), gm = *(const LAS f32x4*)(cM + 4 * lane + 256 * j);
                    const f32x4 x1 = xv[q][j] + gm * m * rstdm;
                    __builtin_nontemporal_store(x1 + g * y * rstd0, orow + 64 * j); }
            }
        }
    }
}

#define XB_TMO      128
#define XB_XCNT(j)  (256  + 64 * (j))
#define XB_XSUB(j)  (1280 + 64 * (j))
#define XB_XGEN(j)  (2304 + 64 * (j))
#define XB_TOP      3328
#define XB_TOPGEN   3392
#define XCD_BAR_WORDS 3456
#define XB_SPIN_CAP (1u << 18)
__device__ __forceinline__ unsigned xb_ld(unsigned* p)              { return __hip_atomic_load(p, __ATOMIC_RELAXED, __HIP_MEMORY_SCOPE_AGENT); }
__device__ __forceinline__ unsigned xb_add(unsigned* p, unsigned v) { return __hip_atomic_fetch_add(p, v, __ATOMIC_RELAXED, __HIP_MEMORY_SCOPE_AGENT); }
__device__ __forceinline__ unsigned xb_xcc_id() { return (unsigned)__builtin_amdgcn_s_getreg((3 << 11) | 20) & 0xFu; }
#define XB_SPIN(cond, bar) do { unsigned _sp = 0; while (cond) { __builtin_amdgcn_s_sleep(1); \
    if ((++_sp & 255u) == 0u) { if (xb_ld(&(bar)[XB_TMO])) break; if (_sp > XB_SPIN_CAP) { atomicAdd(&(bar)[XB_TMO], 1u); break; } } } } while (0)
struct XcdBarrier { unsigned* bar; unsigned x; volatile LAS unsigned* st; };
__device__ __forceinline__ XcdBarrier xcd_barrier_post(unsigned* bar, volatile LAS unsigned* st) {
    XcdBarrier b; b.bar = bar; b.x = xb_xcc_id(); b.st = st;
    if (threadIdx.x == 0) (void)xb_add(&bar[XB_XCNT(b.x)], 1u);
    return b;
}
__device__ __forceinline__ void xcd_barrier_complete(unsigned* bar, unsigned x, unsigned& nloc, unsigned& nx) {
    const unsigned G = gridDim.x * gridDim.y * gridDim.z;
    unsigned sum, cnt, mine, sp = 0u;
    for (;;) {
        sum = 0u; cnt = 0u; mine = 0u;
#pragma unroll
        for (unsigned j = 0; j < 16; ++j) { const unsigned c = xb_ld(&bar[XB_XCNT(j)]); sum += c; cnt += (c > 0u) ? 1u : 0u; mine = (j == x) ? c : mine; }
        if (sum == G) break;
        __builtin_amdgcn_s_sleep(1);
        if ((++sp & 255u) == 0u) { if (xb_ld(&bar[XB_TMO])) break; if (sp > XB_SPIN_CAP) { atomicAdd(&bar[XB_TMO], 1u); break; } }
    }
    nloc = mine > 0u ? mine : 1u; nx = cnt > 0u ? cnt : 1u;
}
__device__ __forceinline__ void xcd_barrier(const XcdBarrier& b) {
    asm volatile("s_waitcnt vmcnt(0)" ::: "memory");
    __syncthreads();
    if (threadIdx.x == 0) {
        unsigned* bar = b.bar;
        __builtin_amdgcn_s_waitcnt(0);
        unsigned nloc = b.st[0], nx = b.st[1];
        if (nloc == 0u) { xcd_barrier_complete(bar, b.x, nloc, nx); b.st[0] = nloc; b.st[1] = nx; }
        const unsigned old = xb_add(&bar[XB_XSUB(b.x)], 1u);
        const unsigned gen = old / nloc;
        if (old + 1u == (gen + 1u) * nloc) {
            __builtin_amdgcn_fence(__ATOMIC_RELEASE, "agent");
            asm volatile("s_waitcnt vmcnt(0)" ::: "memory");
            const unsigned og = xb_add(&bar[XB_TOP], 1u);
            const unsigned tg = og / nx;
            if (og + 1u == (tg + 1u) * nx) xb_add(&bar[XB_TOPGEN], 1u);
            else XB_SPIN(xb_ld(&bar[XB_TOPGEN]) == tg, bar);
            __builtin_amdgcn_fence(__ATOMIC_ACQUIRE, "agent");
            xb_add(&bar[XB_XGEN(b.x)], 1u);
            asm volatile("s_waitcnt vmcnt(0)" ::: "memory");
        } else {
            XB_SPIN(xb_ld(&bar[XB_XGEN(b.x)]) == gen, bar);
            __builtin_amdgcn_fence(__ATOMIC_ACQUIRE, "agent");
            asm volatile("s_waitcnt vmcnt(0)" ::: "memory");
        }
    }
    __syncthreads();
}

constexpr int NPHASE = 10;
__global__ void __launch_bounds__(NTHREADS, 2) fwd(Args args) {
    extern __shared__ __attribute__((aligned(16))) unsigned char lds_raw[];
    LAS unsigned char* lds = (LAS unsigned char*)lds_raw;
    const int lo = args.ph_lo, hi = args.ph_hi;
    unsigned char* ws = args.ws;
    volatile LAS unsigned* bst = (volatile LAS unsigned*)(lds + LDS_BYTES - 32);
    if (threadIdx.x < 2) bst[threadIdx.x] = 0u;
    __syncthreads();
    XcdBarrier bar; bar.bar = (unsigned*)(ws + WS_CTL) + CW_BAR; bar.x = 0; bar.st = bst;
    if (hi - lo > 1) bar = xcd_barrier_post((unsigned*)(ws + WS_CTL) + CW_BAR, bst);
#define SEAM(k) do { if (IN(k) && IN((k) + 1)) { xcd_barrier(bar); } } while (0)
#ifndef PHMASK
#define PHMASK 0x3ff
#endif
#define IN(k) ((PHMASK >> (k) & 1) && lo <= (k) && (k) < hi)
    if (IN(0)) { phase0(args, lds); } SEAM(0);
    if (IN(1)) { phase1(args, lds); } SEAM(1);
    if (IN(2)) {
        pg8::Gemm g{(const bf16_t*)args.out, (const bf16_t*)(ws + WS_WEXT), TOK, NPROJ, DM}; pg8::StaticOrder S; S.init(TOK, NPROJ, gridDim.x, blockIdx.x);
        pg8::EpiBf16 E{(bf16_t*)(ws + WS_PROJ), NPROJ, 2, C2};
        pg8::gemm_phase<pg8::EpiBf16, pg8::StaticOrder, true, true>(lds, g, S, E);
    } SEAM(2);
    if (IN(3)) { phase3(args, lds); } SEAM(3);
    if (IN(4)) { phase4(args, lds); } SEAM(4);
    if (IN(5)) {
        pg8::Gemm g{(const bf16_t*)((unsigned char*)args.out + 64 * MiB), (const bf16_t*)(ws + WS_WOUT), TOK, DM, DM}; pg8::StaticOrder S; S.init(TOK, DM, gridDim.x, blockIdx.x);
        pg8::EpiBf16Ssq E{(bf16_t*)(ws + WS_YMIX), DM, (float*)(ws + WS_SSQ1)};
        pg8::gemm_phase<pg8::EpiBf16Ssq, pg8::StaticOrder, true, true>(lds, g, S, E);
    } SEAM(5);
    if (IN(6)) { phase6(args, lds); } SEAM(6);
    if (IN(7)) {
        pg8::Gemm g{(const bf16_t*)(ws + WS_H2), (const bf16_t*)(ws + WS_WGU), TOK, 2 * FFH, DM}; pg8::StaticOrder S; S.init(TOK, 2 * FFH, gridDim.x, blockIdx.x);
        pg8::EpiSwiGlu E{(bf16_t*)(ws + WS_HID), FFH};
        pg8::gemm_phase<pg8::EpiSwiGlu, pg8::StaticOrder, true, true>(lds, g, S, E);
    } SEAM(7);
    if (IN(8)) {
        pg8::Gemm g{(const bf16_t*)(ws + WS_HID), (const bf16_t*)(ws + WS_WDN), TOK, DM, FFH}; pg8::StaticOrder S; S.init(TOK, DM, gridDim.x, blockIdx.x);
        pg8::EpiBf16Ssq E{(bf16_t*)(ws + WS_F), DM, (float*)(ws + WS_SSQ2)};
        pg8::gemm_phase<pg8::EpiBf16Ssq, pg8::StaticOrder, true, true>(lds, g, S, E);
    } SEAM(8);
    if (IN(9)) { phase9(args, lds); }
#undef IN
#undef SEAM
}

extern "C" void kernel_launch(void* const* d_in, const int* in_sizes, int n_in, void* d_out, int out_size, void* d_ws, size_t ws_size, hipStream_t stream) {
    static int grid = 0;
    if (grid == 0) {
        if (n_in != 37 || out_size != TOK * DM || ws_size < WS_END) { fprintf(stderr, "kernel_launch: unexpected shapes (n_in %d out %d ws %zu)\n", n_in, out_size, ws_size); grid = -1; return; }
        int dev = 0, cus = 0, per_cu = 0;
        hipGetDevice(&dev); hipDeviceGetAttribute(&cus, hipDeviceAttributeMultiprocessorCount, dev);
        hipFuncSetAttribute((const void*)fwd, hipFuncAttributeMaxDynamicSharedMemorySize, LDS_BYTES);
        hipOccupancyMaxActiveBlocksPerMultiprocessor(&per_cu, (const void*)fwd, NTHREADS, LDS_BYTES);
        (void)hipGetLastError();
        if (per_cu < 1) { fprintf(stderr, "kernel_launch: occupancy query says %d blocks per CU\n", per_cu); per_cu = 1; }
        grid = cus;
        fprintf(stderr, "kernel_launch: cus %d per_cu %d grid %d ws %zu\n", cus, per_cu, grid, ws_size);
    }
    if (grid < 0) return;
    hipMemsetAsync((char*)d_ws + WS_CTL, 0, CTL_ZERO_BYTES, stream);
    Args a{};
    for (int i = 0; i < 37; ++i) a.in[i] = (const float*)d_in[i];
    a.out = (float*)d_out; a.ws = (unsigned char*)d_ws;
#if defined(PROBE_DOUBLE)
    for (int p = 0; p < NPHASE; ++p) { a.ph_lo = p; a.ph_hi = p + 1; a.flags = 0; hipLaunchKernelGGL(fwd, dim3(grid), dim3(NTHREADS), LDS_BYTES, stream, a);
        if ((PROBE_DOUBLE >> p) & 1) { if (p == 4) { hipMemsetAsync((char*)d_ws + WS_CTL, 0, CTL_ZERO_BYTES, stream); a.flags = PROBE_P4FLAGS; }
            hipLaunchKernelGGL(fwd, dim3(grid), dim3(NTHREADS), LDS_BYTES, stream, a); } }
#elif N_LAUNCH_MODE == 1
    a.ph_lo = 0; a.ph_hi = NPHASE;
    void* kargs[] = {&a};
    hipError_t e = hipLaunchCooperativeKernel((const void*)fwd, dim3(grid), dim3(NTHREADS), kargs, LDS_BYTES, stream);
    if (e != hipSuccess) fprintf(stderr, "cooperative launch failed: %s (grid %d)\n", hipGetErrorString(e), grid);
#else
    for (int p = 0; p < NPHASE; ++p) { a.ph_lo = p; a.ph_hi = p + 1; hipLaunchKernelGGL(fwd, dim3(grid), dim3(NTHREADS), LDS_BYTES, stream, a); }
#endif
}
```

```cpp
#include <hip/hip_runtime.h>
#include <hip/hip_cooperative_groups.h>
#include <cstdio>
#include <cstdint>
namespace cg = cooperative_groups;

#ifndef PROBE_P4FLAGS
#define PROBE_P4FLAGS 0
#endif
#ifndef N_LAUNCH_MODE
#define N_LAUNCH_MODE 1
#endif

#define LAS __attribute__((address_space(3)))
typedef unsigned short bf16_t;
typedef short bf16x8 __attribute__((ext_vector_type(8)));
typedef short s16x4 __attribute__((ext_vector_type(4)));
typedef float f32x2 __attribute__((ext_vector_type(2)));
typedef float f32x4 __attribute__((ext_vector_type(4)));
typedef float f32x16 __attribute__((ext_vector_type(16)));
typedef unsigned u32x2 __attribute__((ext_vector_type(2)));
typedef unsigned u32x4 __attribute__((ext_vector_type(4)));
typedef __bf16 bf16x2_t __attribute__((ext_vector_type(2)));

constexpr int NB = 8, SEQ = 4096, DM = 1024, TOK = NB * SEQ;
constexpr int NPROJ = 3584;
constexpr int NPA = 1536;
constexpr int FFH = 2816;
constexpr int NTHREADS = 512, NWAVES = 8;
constexpr int LDS_BYTES = 147456;
constexpr float C2 = 0.125f * 1.4426950408889634f;
constexpr float RMS_EPS = 1e-6f, SUBLN_EPS = 1e-5f, LNX_EPS = 64e-5f;

constexpr size_t MiB = 1u << 20;
constexpr size_t WS_CTL = 0, CTL_ZERO_BYTES = 64 * 1024;
constexpr size_t WS_WEXT = 1 * MiB;
constexpr size_t WS_WOUT = 8 * MiB;
constexpr size_t WS_WGU = 10 * MiB;
constexpr size_t WS_WDN = 21 * MiB;
constexpr size_t WS_W2T = 27 * MiB;
constexpr size_t WS_A2T = WS_W2T + 65536;
constexpr size_t WS_G2T = WS_A2T + 65536;
constexpr size_t WS_ADAP = 28 * MiB;
constexpr size_t WS_SSQ1 = 31 * MiB - 0;
constexpr size_t WS_BONUS = 33 * MiB;
constexpr size_t WS_SSQ2 = 34 * MiB;
constexpr size_t WS_PROJ = 36 * MiB;
constexpr size_t WS_PROJR = WS_PROJ + (size_t)32768 * 1536 * 2;
constexpr size_t WS_H2 = WS_PROJ;
constexpr size_t WS_F = WS_PROJ + 64 * MiB;
constexpr size_t WS_SCAN = 260 * MiB;
constexpr size_t WS_YMIX = WS_SCAN;
constexpr size_t WS_HID = WS_SCAN + 64 * MiB;
constexpr size_t WS_END = 500 * MiB;
constexpr size_t WS_OPS = WS_SCAN;
constexpr int OPS_STRIDE = 14336;
constexpr int OP_RP = 0, OP_WT = 2048, OP_ZT = 4096, OP_ARBT = 4608, OP_ARKT = 5120, OP_BH = 5632, OP_KH = 7680, OP_V = 9728, OP_G = 11776, OP_GC = 13824, OP_BON = 14080;

constexpr int CW_QUEUE = 0;
constexpr int CW_BAR = 4096;

__device__ __forceinline__ unsigned pk2(float lo, float hi) { f32x2 v = {lo, hi}; bf16x2_t b = __builtin_convertvector(v, bf16x2_t); return __builtin_bit_cast(unsigned, b); }
__device__ __forceinline__ float bf2f(unsigned short h) { return __uint_as_float(((unsigned)h) << 16); }
__device__ __forceinline__ float bflo(unsigned w) { return __uint_as_float(w << 16); }
__device__ __forceinline__ float bfhi(unsigned w) { return __uint_as_float(w & 0xffff0000u); }
#define LDS_WAIT() asm volatile("s_waitcnt lgkmcnt(0)" ::: "memory")

namespace pg8 {
constexpr int BM = 256, BK = 64, HALF = 128, HTB = HALF * BK * 2, STAGE_BYTES = 8 * HTB, NXCD = 8, WGM = 8;
__host__ __device__ __forceinline__ int lds_byte(int r, int c) { const int st = (r >> 4) * 2 + (c >> 5), rr = r & 15, cc = c & 31, ob = rr * 64 + cc * 2; return st * 1024 + (ob ^ (((ob >> 9) & 1) << 5)); }
__host__ __device__ __forceinline__ void stage_rc(int b, int& R, int& C) { const int st = b / 1024, sb = b % 1024, swz = sb ^ (((sb >> 9) & 1) << 5); R = (st >> 1) * 16 + swz / 64; C = (st & 1) * 32 + (swz % 64) / 2; }
__host__ __device__ __forceinline__ int perm32(int rho) { const int n = rho >> 4, i = rho & 15; return 8 * (i >> 2) + 4 * n + (i & 3); }
struct Unit { int pm, pn; };
struct Gemm { const bf16_t* A; const bf16_t* Bt; int M, N, K; };
struct StaticOrder {
    int nM, nN, nwg, G, c;
    __host__ __device__ void init(int M, int N, int G_, int c_) { nM = M / BM; nN = N / BM; nwg = nM * nN; G = G_; c = c_; }
    __host__ __device__ bool next(int i, Unit& u) const {
        const long L = (long)i * G + c; if (L >= nwg) return false;
        int wgid = (int)L; { const int q = nwg / NXCD, r = nwg % NXCD, xcd = wgid % NXCD, off = wgid / NXCD; wgid = (xcd < r ? xcd * (q + 1) : r * (q + 1) + (xcd - r) * q) + off; }
        const int nig = WGM * nN, gid = wgid / nig, fm = gid * WGM, gsz = (nM - fm) < WGM ? (nM - fm) : WGM;
        u.pm = fm + ((wgid % nig) % gsz); u.pn = (wgid % nig) / gsz; return true;
    }
    __device__ __forceinline__ void a_ready(const Unit&) const {}
    __device__ __forceinline__ void done(const Unit&) const {}
};
struct EpiProj {
    static constexpr bool PERM = true, AFTER_DRAIN = false;
    bf16_t* A; bf16_t* R; float scale0;
    __device__ __forceinline__ void operator()(const f32x4 (&acc)[2][2][4][2], const Unit& u, int wr, int wc, int fr, int fq) const {
        const int row0 = u.pm * BM + wr * 64 + fr; const int col0 = u.pn * BM + wc * 32 + 8 * fq;
        const float sc = (u.pn < 2) ? scale0 : 1.f; const bool att = (u.pn < 6);
#pragma unroll
        for (int ai = 0; ai < 2; ++ai)
#pragma unroll
            for (int m = 0; m < 4; ++m) { const int row = row0 + ai * HALF + m * 16;
#pragma unroll
                for (int bj = 0; bj < 2; ++bj) { const f32x4 v0 = acc[ai][bj][m][0] * sc, v1 = acc[ai][bj][m][1] * sc; const int col = col0 + bj * HALF;
                    u32x4 w; w.x = pk2(v0[0], v0[1]); w.y = pk2(v0[2], v0[3]); w.z = pk2(v1[0], v1[1]); w.w = pk2(v1[2], v1[3]);
                    bf16_t* dst = att ? A + (size_t)row * 1536 + col : R + ((size_t)(row >> 4) * 128 + ((col - 1536) >> 4)) * 256 + (row & 15) * 16 + (col & 15);
                    *(u32x4*)dst = w; } }
    }
};
struct EpiBf16Ssq {
    static constexpr bool PERM = true, AFTER_DRAIN = false;
    bf16_t* O; int ldc; float* ssq;
    __device__ __forceinline__ void operator()(const f32x4 (&acc)[2][2][4][2], const Unit& u, int wr, int wc, int fr, int fq) const {
        const int row0 = u.pm * BM + wr * 64 + fr; const int col0 = u.pn * BM + wc * 32 + 8 * fq;
#pragma unroll
        for (int ai = 0; ai < 2; ++ai)
#pragma unroll
            for (int m = 0; m < 4; ++m) { const int row = row0 + ai * HALF + m * 16; bf16_t* rowp = O + (size_t)row * ldc + col0; float s = 0.f;
#pragma unroll
                for (int bj = 0; bj < 2; ++bj) { const f32x4 v0 = acc[ai][bj][m][0], v1 = acc[ai][bj][m][1];
                    s += (v0[0] * v0[0] + v0[1] * v0[1]) + (v0[2] * v0[2] + v0[3] * v0[3]) + (v1[0] * v1[0] + v1[1] * v1[1]) + (v1[2] * v1[2] + v1[3] * v1[3]);
                    u32x4 w; w.x = pk2(v0[0], v0[1]); w.y = pk2(v0[2], v0[3]); w.z = pk2(v1[0], v1[1]); w.w = pk2(v1[2], v1[3]);
                    *(u32x4*)(rowp + bj * HALF) = w; }
                s += __shfl_xor(s, 16); s += __shfl_xor(s, 32);
                if (fq == 0) ssq[(size_t)row * 16 + u.pn * 4 + wc] = s; }
    }
};
struct EpiSwiGlu {
    static constexpr bool PERM = true, AFTER_DRAIN = false;
    bf16_t* O; int ldc;
    __device__ __forceinline__ void operator()(const f32x4 (&acc)[2][2][4][2], const Unit& u, int wr, int wc, int fr, int fq) const {
        const int row0 = u.pm * BM + wr * 64 + fr; const int col0 = u.pn * HALF + wc * 32 + 8 * fq;
#pragma unroll
        for (int ai = 0; ai < 2; ++ai)
#pragma unroll
            for (int m = 0; m < 4; ++m) { bf16_t* rowp = O + (size_t)(row0 + ai * HALF + m * 16) * ldc + col0; float h[8];
#pragma unroll
                for (int n = 0; n < 2; ++n)
#pragma unroll
                    for (int e = 0; e < 4; ++e) { const float g = acc[ai][0][m][n][e], up = acc[ai][1][m][n][e];
                        const float sg = g * __builtin_amdgcn_rcpf(1.f + __builtin_amdgcn_exp2f(-1.4426950408889634f * g)); h[n * 4 + e] = sg * up; }
                u32x4 w; w.x = pk2(h[0], h[1]); w.y = pk2(h[2], h[3]); w.z = pk2(h[4], h[5]); w.w = pk2(h[6], h[7]);
                *(u32x4*)rowp = w; }
    }
};

template <class Epi, class Sched, bool ALIGN_EPI = false, bool SP2 = false>
__device__ __forceinline__ void gemm_phase(LAS unsigned char* lds, const Gemm g, const Sched& S, const Epi& E) {
    const int tid = threadIdx.x, wid = __builtin_amdgcn_readfirstlane(tid >> 6), lane = tid & 63, wr = wid >> 2, wc = wid & 3, fr = lane & 15, fq = lane >> 4;
    const int K = g.K, nt = K / BK;
    unsigned voffA[2], voffB[2];
#pragma unroll
    for (int i = 0; i < 2; ++i) { int R, C; stage_rc(tid * 16 + i * 8192, R, C); const int Rb = Epi::PERM ? ((R & ~31) + perm32(R & 31)) : R;
        voffA[i] = (unsigned)(R * K + C) * 2u; voffB[i] = (unsigned)(Rb * K + C) * 2u; }
    const size_t kstep = (size_t)(BK * 2);
    const size_t hstep = (size_t)HALF * K * 2;
    const size_t tstep = 2 * hstep;
    const unsigned ldsw = (unsigned)wid * 1024u;
    const int aoff = lds_byte(wr * 64 + fr, fq * 8), boff = lds_byte(wc * 32 + fr, fq * 8);
#define PG8_SA(b, h) (((b) * 2 + (h)) * HTB)
#define PG8_SB(b, h) ((4 + (b) * 2 + (h)) * HTB)
#define PG8_STAGE(bufoff, gbase, voff) do { _Pragma("unroll") for (int _i = 0; _i < 2; ++_i) \
        __builtin_amdgcn_global_load_lds((const unsigned*)((const char*)(gbase) + (voff)[_i]), (LAS unsigned*)(lds + (bufoff) + ldsw + _i * 8192), 16, 0, 0); } while (0)
#define PG8_LDA(dst, b, h) do { _Pragma("unroll") for (int m = 0; m < 4; ++m) _Pragma("unroll") for (int k = 0; k < 2; ++k) dst[m][k] = *(const LAS bf16x8*)(lds + PG8_SA(b, h) + aoff + m * 2048 + k * 1024); } while (0)
#define PG8_LDB(dst, b, h) do { _Pragma("unroll") for (int n = 0; n < 2; ++n) _Pragma("unroll") for (int k = 0; k < 2; ++k) dst[n][k] = *(const LAS bf16x8*)(lds + PG8_SB(b, h) + boff + n * 2048 + k * 1024); } while (0)
#define PG8_MMA(ai, bj, At, Bt) do { __builtin_amdgcn_s_setprio(1); _Pragma("unroll") for (int m = 0; m < 4; ++m) _Pragma("unroll") for (int n = 0; n < 2; ++n) _Pragma("unroll") for (int k = 0; k < 2; ++k) \
        acc[ai][bj][m][n] = __builtin_amdgcn_mfma_f32_16x16x32_bf16(Bt[n][k], At[m][k], acc[ai][bj][m][n], 0, 0, 0); __builtin_amdgcn_s_setprio(0); } while (0)
#define PG8_WAIT_V(n) asm volatile("s_waitcnt vmcnt(" #n ")" ::: "memory")
#define PG8_WAIT_L(n) asm volatile("s_waitcnt lgkmcnt(" #n ")" ::: "memory")
#define PG8_BAR __builtin_amdgcn_s_barrier()
#define PG8_SCHED __builtin_amdgcn_sched_barrier(0)
    Unit cur, nxt; int ui = 0;
    if (!S.next(0, cur)) return;
    f32x4 acc[2][2][4][2];
#pragma unroll
    for (int a = 0; a < 2; ++a)
#pragma unroll
        for (int b = 0; b < 2; ++b)
#pragma unroll
            for (int m = 0; m < 4; ++m)
#pragma unroll
                for (int n = 0; n < 2; ++n) acc[a][b][m][n] = (f32x4){0.f, 0.f, 0.f, 0.f};
    bf16x8 At[4][2], B0[2][2], B1[2][2];
    const char* cA = (const char*)g.A + (size_t)cur.pm * tstep; const char* cB = (const char*)g.Bt + (size_t)cur.pn * tstep;
    S.a_ready(cur);
    if constexpr (SP2) {
        PG8_STAGE(PG8_SB(0, 0), cB, voffB); PG8_STAGE(PG8_SB(0, 1), cB + hstep, voffB); PG8_STAGE(PG8_SA(0, 0), cA, voffA); PG8_STAGE(PG8_SA(0, 1), cA + hstep, voffA);
        if (wr == 1) PG8_BAR;
        PG8_WAIT_V(2); PG8_BAR;
        PG8_STAGE(PG8_SB(1, 0), cB + kstep, voffB); PG8_STAGE(PG8_SA(1, 0), cA + kstep, voffA); PG8_STAGE(PG8_SB(1, 1), cB + hstep + kstep, voffB);
        PG8_WAIT_V(6); PG8_BAR;
    } else {
        PG8_STAGE(PG8_SB(0, 0), cB, voffB); PG8_STAGE(PG8_SA(0, 0), cA, voffA); PG8_STAGE(PG8_SB(0, 1), cB + hstep, voffB); PG8_STAGE(PG8_SA(0, 1), cA + hstep, voffA);
        if (wr == 1) PG8_BAR;
        PG8_WAIT_V(4); PG8_BAR;
        PG8_STAGE(PG8_SB(1, 0), cB + kstep, voffB); PG8_STAGE(PG8_SA(1, 0), cA + kstep, voffA); PG8_STAGE(PG8_SB(1, 1), cB + hstep + kstep, voffB);
        PG8_WAIT_V(6); PG8_BAR;
    }
    for (;;) {
        const bool has_next = S.next(ui + 1, nxt);
        const char* nA = has_next ? (const char*)g.A + (size_t)nxt.pm * tstep : cA; const char* nB = has_next ? (const char*)g.Bt + (size_t)nxt.pn * tstep : cB;
        for (int t = 0; t < nt; t += 2) {
            const bool last = (t == nt - 2);
            const char* a1 = cA + (size_t)(t + 1) * kstep;
            const char* a2 = last ? nA : cA + (size_t)(t + 2) * kstep; const char* b2 = last ? nB : cB + (size_t)(t + 2) * kstep;
            const char* a3 = a2 + kstep; const char* b3 = b2 + kstep;
            if (last && has_next) S.a_ready(nxt);
            if constexpr (SP2) {
            PG8_LDB(B0, 0, 0); PG8_LDB(B1, 0, 1); PG8_SCHED; PG8_LDA(At, 0, 0); PG8_STAGE(PG8_SA(1, 1), a1 + hstep, voffA);
            PG8_WAIT_V(8); PG8_WAIT_L(0); PG8_BAR; PG8_MMA(0, 0, At, B0); PG8_MMA(0, 1, At, B1); PG8_BAR; PG8_SCHED;
            PG8_LDA(At, 0, 1); PG8_STAGE(PG8_SB(0, 0), b2, voffB); PG8_STAGE(PG8_SB(0, 1), b2 + hstep, voffB); PG8_STAGE(PG8_SA(0, 0), a2, voffA);
            PG8_WAIT_V(8); PG8_WAIT_L(0); PG8_BAR; PG8_MMA(1, 0, At, B0); PG8_MMA(1, 1, At, B1); PG8_BAR; PG8_SCHED;
            PG8_LDB(B0, 1, 0); PG8_LDB(B1, 1, 1); PG8_SCHED; PG8_LDA(At, 1, 0); PG8_STAGE(PG8_SA(0, 1), a2 + hstep, voffA);
            PG8_WAIT_V(8); PG8_WAIT_L(0); PG8_BAR; PG8_MMA(0, 0, At, B0); PG8_MMA(0, 1, At, B1); PG8_BAR; PG8_SCHED;
            PG8_LDA(At, 1, 1); PG8_STAGE(PG8_SB(1, 0), b3, voffB); PG8_STAGE(PG8_SB(1, 1), b3 + hstep, voffB); PG8_STAGE(PG8_SA(1, 0), a3, voffA);
            PG8_WAIT_V(8); PG8_WAIT_L(0); PG8_BAR; PG8_MMA(1, 0, At, B0); PG8_MMA(1, 1, At, B1); PG8_BAR; PG8_SCHED;
            } else {
            PG8_LDB(B0, 0, 0); PG8_SCHED; PG8_LDA(At, 0, 0); PG8_STAGE(PG8_SA(1, 1), a1 + hstep, voffA);
            PG8_WAIT_L(8); PG8_BAR; PG8_WAIT_L(0); PG8_MMA(0, 0, At, B0); PG8_BAR; PG8_SCHED;
            PG8_LDB(B1, 0, 1); PG8_STAGE(PG8_SB(0, 0), b2, voffB);
            PG8_BAR; PG8_WAIT_L(0); PG8_MMA(0, 1, At, B1); PG8_BAR;
            PG8_LDA(At, 0, 1); PG8_STAGE(PG8_SA(0, 0), a2, voffA);
            PG8_BAR; PG8_WAIT_L(0); PG8_MMA(1, 0, At, B0); PG8_BAR; PG8_SCHED;
            PG8_STAGE(PG8_SB(0, 1), b2 + hstep, voffB);
            PG8_WAIT_V(6); PG8_BAR; PG8_MMA(1, 1, At, B1); PG8_BAR;
            PG8_LDB(B0, 1, 0); PG8_SCHED; PG8_LDA(At, 1, 0); PG8_STAGE(PG8_SA(0, 1), a2 + hstep, voffA);
            PG8_WAIT_L(8); PG8_BAR; PG8_WAIT_L(0); PG8_MMA(0, 0, At, B0); PG8_BAR; PG8_SCHED;
            PG8_LDB(B1, 1, 1); PG8_STAGE(PG8_SB(1, 0), b3, voffB);
            PG8_BAR; PG8_WAIT_L(0); PG8_MMA(0, 1, At, B1); PG8_BAR;
            PG8_LDA(At, 1, 1); PG8_STAGE(PG8_SA(1, 0), a3, voffA);
            PG8_BAR; PG8_WAIT_L(0); PG8_MMA(1, 0, At, B0); PG8_BAR; PG8_SCHED;
            PG8_STAGE(PG8_SB(1, 1), b3 + hstep, voffB);
            PG8_WAIT_V(6); PG8_BAR; PG8_MMA(1, 1, At, B1); PG8_BAR;
            }
        }
        if constexpr (ALIGN_EPI) { if (wr == 0) PG8_BAR; }
        if constexpr (!Epi::AFTER_DRAIN) { E(acc, cur, wr, wc, fr, fq); S.done(cur); }
        if (!has_next) break;
#pragma unroll
        for (int a = 0; a < 2; ++a)
#pragma unroll
            for (int b = 0; b < 2; ++b)
#pragma unroll
                for (int m = 0; m < 4; ++m)
#pragma unroll
                    for (int n = 0; n < 2; ++n) acc[a][b][m][n] = (f32x4){0.f, 0.f, 0.f, 0.f};
        cur = nxt; cA = nA; cB = nB; ++ui;
        if constexpr (ALIGN_EPI) { if (wr == 1) PG8_BAR; }
    }
    PG8_WAIT_V(0);
    if constexpr (!ALIGN_EPI) { if (wr == 0) PG8_BAR; }
    PG8_BAR;
#undef PG8_SA
#undef PG8_SB
#undef PG8_STAGE
#undef PG8_LDA
#undef PG8_LDB
#undef PG8_MMA
#undef PG8_WAIT_V
#undef PG8_WAIT_L
#undef PG8_BAR
#undef PG8_SCHED
}
}

struct Args {
    const float* in[37];
    float* out;
    unsigned char* ws;
    int ph_lo, ph_hi, flags, pad;
};
enum { I_X = 0, I_C, I_WADA, I_BADA, I_GPREMIX, I_GPOSTMIX, I_GPREFFN, I_GPOSTFFN, I_WIN, I_LQ1, I_LK1, I_LQ2, I_LK2, I_SUBLN, I_MUR, I_MUK, I_MUV, I_MUW, I_MUA, I_MUG,
       I_W0, I_W1, I_W2, I_A0, I_A1, I_A2, I_G1, I_G2, I_KK, I_KA, I_RK, I_LNXG, I_LNXB, I_WOUT, I_WGATE, I_WUP, I_WDOWN };

__device__ __forceinline__ const bf16_t* projr(const bf16_t* PR, int t, int colr) { return PR + ((size_t)(t >> 4) * 128 + (colr >> 4)) * 256 + (t & 15) * 16 + (colr & 15); }
__device__ __forceinline__ float wave_sum(float v) {
#pragma unroll
    for (int o = 1; o < 64; o <<= 1) v += __shfl_xor(v, o);
    return v;
}
template <int CTRL> __device__ __forceinline__ float dppf(float x) { return __builtin_bit_cast(float, __builtin_amdgcn_update_dpp(0, __builtin_bit_cast(int, x), CTRL, 0xf, 0xf, true)); }
__device__ __forceinline__ float sum8(float v) { v += dppf<0xB1>(v); v += dppf<0x4E>(v); v += dppf<0x141>(v); return v; }
__device__ __forceinline__ float sum16(float v) { v = sum8(v); v += dppf<0x140>(v); return v; }

__device__ __forceinline__ void tr_item(const float* W, int K, int N, bf16_t* WT, int ldo, int dst_row0, LAS float* scr, int kb, int nb, int lane, const float* mu, int mode) {
    const int k0 = 64 * kb, n0 = 32 * nb;
#pragma unroll 8
    for (int i = 0; i < 32; ++i) { const int kk = 2 * i + (lane >> 5); float v = W[(size_t)(k0 + kk) * N + n0 + (lane & 31)];
        if (mode == 1) v *= (1.f - mu[k0 + kk]); else if (mode == 2) v *= mu[k0 + kk];
        scr[kk * 33 + (lane & 31)] = v; }
    LDS_WAIT(); asm volatile("" ::: "memory");
    const int c = lane & 7;
#pragma unroll
    for (int j = 0; j < 4; ++j) { const int n = (lane >> 3) + 8 * j; const LAS float* s = scr + (8 * c) * 33 + n;
        u32x4 o; o.x = pk2(s[0 * 33], s[1 * 33]); o.y = pk2(s[2 * 33], s[3 * 33]); o.z = pk2(s[4 * 33], s[5 * 33]); o.w = pk2(s[6 * 33], s[7 * 33]);
        *(u32x4*)(WT + (size_t)(dst_row0 + n) * ldo + k0 + 8 * c) = o; }
    LDS_WAIT(); asm volatile("" ::: "memory");
}

__device__ __forceinline__ void phase0(const Args& a, LAS unsigned char* lds) {
    const int tid = threadIdx.x, lane = tid & 63, wid = __builtin_amdgcn_readfirstlane(tid >> 6);
    const int G = gridDim.x;
    LAS float* scr = (LAS float*)(lds + wid * 8704);
    unsigned char* ws = a.ws;
    bf16_t* Wext = (bf16_t*)(ws + WS_WEXT); bf16_t* Wout = (bf16_t*)(ws + WS_WOUT); bf16_t* Wgu = (bf16_t*)(ws + WS_WGU); bf16_t* Wdn = (bf16_t*)(ws + WS_WDN);
    bf16_t* W2t = (bf16_t*)(ws + WS_W2T); bf16_t* A2t = (bf16_t*)(ws + WS_A2T); bf16_t* G2t = (bf16_t*)(ws + WS_G2T);
    const int gw = blockIdx.x * NWAVES + wid, NGW = G * NWAVES;
    constexpr int J0 = 1536, J1 = 32, J5 = 64, J7 = 512, J8 = 1408, J11 = 16, J13 = 32;
    constexpr int NITEMS = J0 + 4 * J1 + 2 * J5 + J7 + 3 * J8 + 2 * J11 + J13;
    for (int it = gw; it < NITEMS; it += NGW) {
        int r = it;
        if (r < J0) { tr_item(a.in[I_WIN], 1024, 3072, Wext, 1024, (r % 96) * 32, scr, r / 96, r % 96, lane, nullptr, 0); continue; } r -= J0;
        if (r < J1) { tr_item(a.in[I_W1], 1024, 64, Wext, 1024, 3072 + (r % 2) * 32, scr, r / 2, r % 2, lane, a.in[I_MUW], 1); continue; } r -= J1;
        if (r < J1) { tr_item(a.in[I_W1], 1024, 64, Wext, 1024, 3136 + (r % 2) * 32, scr, r / 2, r % 2, lane, a.in[I_MUW], 2); continue; } r -= J1;
        if (r < J1) { tr_item(a.in[I_A1], 1024, 64, Wext, 1024, 3200 + (r % 2) * 32, scr, r / 2, r % 2, lane, a.in[I_MUA], 1); continue; } r -= J1;
        if (r < J1) { tr_item(a.in[I_A1], 1024, 64, Wext, 1024, 3264 + (r % 2) * 32, scr, r / 2, r % 2, lane, a.in[I_MUA], 2); continue; } r -= J1;
        if (r < J5) { tr_item(a.in[I_G1], 1024, 128, Wext, 1024, 3328 + (r % 4) * 32, scr, r / 4, r % 4, lane, a.in[I_MUG], 1); continue; } r -= J5;
        if (r < J5) { tr_item(a.in[I_G1], 1024, 128, Wext, 1024, 3456 + (r % 4) * 32, scr, r / 4, r % 4, lane, a.in[I_MUG], 2); continue; } r -= J5;
        if (r < J7) { tr_item(a.in[I_WOUT], 1024, 1024, Wout, 1024, (r % 32) * 32, scr, r / 32, r % 32, lane, nullptr, 0); continue; } r -= J7;
        if (r < J8) { const int nb = r % 88, n0 = nb * 32; tr_item(a.in[I_WGATE], 1024, 2816, Wgu, 1024, 256 * (n0 / 128) + (n0 % 128), scr, r / 88, nb, lane, nullptr, 0); continue; } r -= J8;
        if (r < J8) { const int nb = r % 88, n0 = nb * 32; tr_item(a.in[I_WUP], 1024, 2816, Wgu, 1024, 256 * (n0 / 128) + (n0 % 128) + 128, scr, r / 88, nb, lane, nullptr, 0); continue; } r -= J8;
        if (r < J8) { tr_item(a.in[I_WDOWN], 2816, 1024, Wdn, 2816, (r % 32) * 32, scr, r / 32, r % 32, lane, nullptr, 0); continue; } r -= J8;
        if (r < J11) { tr_item(a.in[I_W2], 64, 512, W2t, 64, r * 32, scr, 0, r, lane, nullptr, 0); continue; } r -= J11;
        if (r < J11) { tr_item(a.in[I_A2], 64, 512, A2t, 64, r * 32, scr, 0, r, lane, nullptr, 0); continue; } r -= J11;
        tr_item(a.in[I_G2], 128, 512, G2t, 128, (r % 16) * 32, scr, r / 16, r % 16, lane, nullptr, 0);
    }
    LAS float* sc = (LAS float*)(lds + 73728);
    const float* cin = a.in[I_C];
    for (int i = tid; i < 8192; i += NTHREADS) { const float v = cin[i]; sc[i] = v * __builtin_amdgcn_rcpf(1.f + __expf(-v)); }
    __syncthreads();
    float* adap = (float*)(ws + WS_ADAP); const float* wada = a.in[I_WADA];
    for (int it = blockIdx.x * NTHREADS + tid; it < 16 * 6144; it += G * NTHREADS) {
        const int col = it % 6144, kc = it / 6144; float acc[8];
#pragma unroll
        for (int b = 0; b < 8; ++b) acc[b] = 0.f;
        for (int k = kc * 64; k < kc * 64 + 64; ++k) { const float w = wada[(size_t)k * 6144 + col];
#pragma unroll
            for (int b = 0; b < 8; ++b) acc[b] += sc[b * 1024 + k] * w; }
#pragma unroll
        for (int b = 0; b < 8; ++b) adap[(size_t)(kc * 8 + b) * 6144 + col] = acc[b];
    }
    __syncthreads();
}
__device__ __forceinline__ float ada_val(const Args& a, int b, int j) {
    const float* adap = (const float*)(a.ws + WS_ADAP); float s = a.in[I_BADA][j];
#pragma unroll
    for (int kc = 0; kc < 16; ++kc) s += adap[(size_t)(kc * 8 + b) * 6144 + j];
    return s;
}

__device__ __forceinline__ void phase1(const Args& a, LAS unsigned char* lds) {
    const int tid = threadIdx.x, lane = tid & 63, wid = __builtin_amdgcn_readfirstlane(tid >> 6);
    LAS float* cA = (LAS float*)lds; LAS float* cB = cA + 1024;
    bf16_t* H1 = (bf16_t*)a.out;
    for (int rb = blockIdx.x; rb < TOK / 128; rb += gridDim.x) {
        const int b = rb / 32;
        __syncthreads();
        for (int j = tid; j < 1024; j += NTHREADS) { cA[j] = a.in[I_GPREMIX][j] * (1.f + ada_val(a, b, 1024 + j)); cB[j] = ada_val(a, b, j); }
        __syncthreads();
        for (int rr = wid; rr < 128; rr += 2 * NWAVES) {
            const size_t row0 = (size_t)rb * 128 + rr;
            f32x4 v[2][4]; float s[2] = {0.f, 0.f};
#pragma unroll
            for (int q = 0; q < 2; ++q) { const f32x4* xr = (const f32x4*)(a.in[I_X] + (row0 + q * NWAVES) * DM) + lane;
#pragma unroll
                for (int j = 0; j < 4; ++j) v[q][j] = __builtin_nontemporal_load(xr + 64 * j); }
#pragma unroll
            for (int q = 0; q < 2; ++q) {
#pragma unroll
                for (int j = 0; j < 4; ++j) s[q] += (v[q][j].x * v[q][j].x + v[q][j].y * v[q][j].y) + (v[q][j].z * v[q][j].z + v[q][j].w * v[q][j].w);
                const float rstd = 1.0f / sqrtf(wave_sum(s[q]) * (1.f / DM) + RMS_EPS);
                unsigned long long* o8 = (unsigned long long*)(H1 + (row0 + q * NWAVES) * DM) + lane;
#pragma unroll
                for (int j = 0; j < 4; ++j) { const f32x4 ca = *(const LAS f32x4*)(cA + 4 * lane + 256 * j), cb = *(const LAS f32x4*)(cB + 4 * lane + 256 * j);
                    const f32x4 h = v[q][j] * rstd * ca + cb;
                    o8[64 * j] = (unsigned long long)pk2(h.x, h.y) | ((unsigned long long)pk2(h.z, h.w) << 32); }
            }
        }
    }
}

__device__ __forceinline__ float tanh_f(float x) { const float e = __expf(2.f * x); return 1.f - 2.f * __builtin_amdgcn_rcpf(e + 1.f); }
__device__ __forceinline__ float sigm_f(float x) { return __builtin_amdgcn_rcpf(1.f + __expf(-x)); }
typedef short v4i16_t __attribute__((ext_vector_type(4)));
__device__ __forceinline__ s16x4 vtr(const LAS unsigned char* p) { return __builtin_bit_cast(s16x4, __builtin_amdgcn_ds_read_tr16_b64_v4i16((LAS v4i16_t*)p)); }
__device__ __forceinline__ float prefix16(float x) { x += dppf<0x111>(x); x += dppf<0x112>(x); x += dppf<0x114>(x); x += dppf<0x118>(x); return x; }
__device__ __forceinline__ bf16x8 pack8(const float* v) { u32x4 w = (u32x4){pk2(v[0], v[1]), pk2(v[2], v[3]), pk2(v[4], v[5]), pk2(v[6], v[7])}; return __builtin_bit_cast(bf16x8, w); }
__device__ __forceinline__ bf16x8 pack4z(float a, float b, float c, float d) { u32x4 w = (u32x4){pk2(a, b), pk2(c, d), 0u, 0u}; return __builtin_bit_cast(bf16x8, w); }
__device__ __forceinline__ void phase3(const Args& a, LAS unsigned char* lds) {
    const int tid = threadIdx.x, lane = tid & 63, wid = __builtin_amdgcn_readfirstlane(tid >> 6);
    const bf16_t* PR = (const bf16_t*)(a.ws + WS_PROJR);
    const bf16_t* W2t = (const bf16_t*)(a.ws + WS_W2T); const bf16_t* A2t = (const bf16_t*)(a.ws + WS_A2T); const bf16_t* G2t = (const bf16_t*)(a.ws + WS_G2T);
    constexpr int XP = 264;
    LAS bf16_t* Xs = (LAS bf16_t*)(lds + wid * 8448);
    LAS unsigned char* AIMG = lds + 67584 + wid * 3072;
    LAS float* ATL = (LAS float*)(AIMG + 2048);
    const int fr = lane & 15, fq = lane >> 4;
    LAS float* CT = (LAS float*)(lds + 92160);
    { const int ch = tid;
      CT[ch] = a.in[I_MUR][ch]; CT[512 + ch] = a.in[I_MUK][ch]; CT[1024 + ch] = a.in[I_MUV][ch]; CT[1536 + ch] = a.in[I_W0][ch];
      CT[2048 + ch] = a.in[I_A0][ch]; CT[2560 + ch] = a.in[I_KK][ch]; CT[3072 + ch] = a.in[I_KA][ch]; CT[3584 + ch] = a.in[I_RK][ch]; }
    LAS unsigned char* WB = lds + 108544;
    const unsigned char* wsrc[4];
#pragma unroll
    for (int q = 0; q < 4; ++q) { const int pz = wid * 4 + q;
        if (pz < 16) { const int row = 8 * (pz & 7) + (lane >> 3), pc = lane & 7, lc = pc ^ ((row >> 1) & 7);
            wsrc[q] = (const unsigned char*)((pz < 8) ? W2t : A2t) + row * 128 + lc * 16; }
        else { const int row = 4 * (pz - 16) + (lane >> 4), pc = lane & 15, lc = pc ^ (row & 15);
            wsrc[q] = (const unsigned char*)G2t + row * 256 + lc * 16; } }
    const int whs = (wid < 4) ? 8192 : 16384;
#define P3_WDMA(hd_) do { _Pragma("unroll") for (int q_ = 0; q_ < 4; ++q_) \
        __builtin_amdgcn_global_load_lds((const unsigned*)(wsrc[q_] + (size_t)(hd_) * whs), (LAS unsigned*)(WB + (wid * 4 + q_) * 1024), 16, 0, 0); } while (0)
    __syncthreads();
    for (int tt = blockIdx.x * NWAVES + wid; tt < TOK / 16; tt += gridDim.x * NWAVES) {
        const int t0 = tt * 16;
        P3_WDMA(0);
        {
            const int xtok = lane >> 2, xp = lane & 3; const int tx = t0 + xtok; const bool hp = (tx % SEQ) != 0;
            const int txp = tx - (hp ? 1 : 0);
#pragma unroll
            for (int jb = 0; jb < 2; ++jb) {
                u32x4 cw4[4], pw4[4];
#pragma unroll
                for (int jj = 0; jj < 4; ++jj) { const int j = 4 * jb + jj, j8 = (xp + 4 * j) * 8;
                    const int ccur = (j < 2) ? 3072 + j8 : (j < 4) ? 3200 + (j8 - 64) : 3328 + (j8 - 128), cprev = (j < 2) ? 3136 + j8 : (j < 4) ? 3264 + (j8 - 64) : 3456 + (j8 - 128);
                    cw4[jj] = *(const u32x4*)projr(PR, tx, ccur - 1536); pw4[jj] = *(const u32x4*)projr(PR, txp, cprev - 1536); if (!hp) pw4[jj] = (u32x4){0u, 0u, 0u, 0u}; }
#pragma unroll
                for (int jj = 0; jj < 4; ++jj) { const int j = 4 * jb + jj, j8 = (xp + 4 * j) * 8; unsigned o[4];
#pragma unroll
                    for (int i = 0; i < 4; ++i) { float lo = bflo(cw4[jj][i]) + bflo(pw4[jj][i]), hi = bfhi(cw4[jj][i]) + bfhi(pw4[jj][i]);
                        if (j < 2) { lo = tanh_f(lo); hi = tanh_f(hi); } else if (j >= 4) { lo = sigm_f(lo); hi = sigm_f(hi); }
                        o[i] = pk2(lo, hi); }
                    *(LAS u32x4*)(Xs + xtok * XP + j8) = (u32x4){o[0], o[1], o[2], o[3]}; }
            }
        }
        LDS_WAIT(); asm volatile("" ::: "memory");
        const int t = t0 + fr; const bool has_prev = (t % SEQ) != 0;
        const int bb = t0 / SEQ, cc = (t0 % SEQ) / 16;
        const int tp = t - (has_prev ? 1 : 0);
#pragma unroll 1
        for (int hd = 0; hd < 8; ++hd) {
        if (hd == 0) asm volatile("s_waitcnt vmcnt(0)\n\ts_barrier" ::: "memory"); else asm volatile("s_waitcnt vmcnt(8)\n\ts_barrier" ::: "memory");
        unsigned char* ops = a.ws + WS_OPS + (size_t)((bb * 8 + hd) * 256 + cc) * OPS_STRIDE;
        if (a.flags & 4) ops = (unsigned char*)a.out + (size_t)(blockIdx.x * 8 + wid) * OPS_STRIDE;
        u32x2 prc[4], pkc[4], pvc[4], prp[4], pkp[4], pvp[4];
#pragma unroll
        for (int i = 0; i < 4; ++i) { const int ch = 64 * hd + 16 * i + 4 * fq;
            prc[i] = *(const u32x2*)projr(PR, t, ch); pkc[i] = *(const u32x2*)projr(PR, t, 512 + ch); pvc[i] = *(const u32x2*)projr(PR, t, 1024 + ch);
            prp[i] = *(const u32x2*)projr(PR, tp, ch); pkp[i] = *(const u32x2*)projr(PR, tp, 512 + ch); pvp[i] = *(const u32x2*)projr(PR, tp, 1024 + ch);
            if (!has_prev) { prp[i] = (u32x2){0u, 0u}; pkp[i] = prp[i]; pvp[i] = prp[i]; } }
        f32x4 lw[4], la[4];
        {   bf16x8 bx[8];
#pragma unroll
            for (int ks = 0; ks < 8; ++ks) bx[ks] = *(const LAS bf16x8*)(Xs + fr * XP + ks * 32 + fq * 8);
#pragma unroll
            for (int i = 0; i < 4; ++i) {
                f32x4 cw = (f32x4){0.f, 0.f, 0.f, 0.f}, ca = cw, cg_ = cw;
#pragma unroll
                for (int ks = 0; ks < 2; ++ks) { const bf16x8 af = *(const LAS bf16x8*)(WB + (16 * i + fr) * 128 + (((ks * 4 + fq) ^ ((fr >> 1) & 7)) * 16)); cw = __builtin_amdgcn_mfma_f32_16x16x32_bf16(af, bx[ks], cw, 0, 0, 0); }
#pragma unroll
                for (int ks = 0; ks < 2; ++ks) { const bf16x8 af = *(const LAS bf16x8*)(WB + 8192 + (16 * i + fr) * 128 + (((ks * 4 + fq) ^ ((fr >> 1) & 7)) * 16)); ca = __builtin_amdgcn_mfma_f32_16x16x32_bf16(af, bx[2 + ks], ca, 0, 0, 0); }
#pragma unroll
                for (int ks = 0; ks < 4; ++ks) { const bf16x8 af = *(const LAS bf16x8*)(WB + 16384 + (16 * i + fr) * 256 + (((ks * 4 + fq) ^ fr) * 16)); cg_ = __builtin_amdgcn_mfma_f32_16x16x32_bf16(af, bx[4 + ks], cg_, 0, 0, 0); }
                lw[i] = cw; la[i] = ca;
                *(u32x2*)(ops + OP_G + i * 512 + fr * 32 + fq * 8) = (u32x2){pk2(cg_[0], cg_[1]), pk2(cg_[2], cg_[3])};
                asm volatile("" ::: "memory");
            }
        }
        float ssq = 0.f;
#pragma unroll
        for (int i = 0; i < 4; ++i) { const int ch = 64 * hd + 16 * i + 4 * fq;
            const f32x4 muk = *(const LAS f32x4*)(CT + 512 + ch), k_k = *(const LAS f32x4*)(CT + 2560 + ch);
#pragma unroll
            for (int e = 0; e < 4; ++e) { const float pk = (e & 1) ? bfhi(pkc[i][e >> 1]) : bflo(pkc[i][e >> 1]), pkv = (e & 1) ? bfhi(pkp[i][e >> 1]) : bflo(pkp[i][e >> 1]);
                const float kkr = (pk + (pkv - pk) * muk[e]) * k_k[e]; ssq += kkr * kkr; } }
        ssq += __shfl_xor(ssq, 16); ssq += __shfl_xor(ssq, 32);
        const float inv = 1.f / fmaxf(sqrtf(ssq), 1e-12f);
#pragma unroll
        for (int i = 0; i < 4; ++i) asm volatile("" :: "v"(prc[i]), "v"(pkc[i]), "v"(pvc[i]), "v"(prp[i]), "v"(pkp[i]), "v"(pvp[i]));
        asm volatile("s_waitcnt lgkmcnt(0)\n\ts_barrier" ::: "memory");
        if (hd < 7) P3_WDMA(hd + 1);
        f32x4 aab = (f32x4){0.f, 0.f, 0.f, 0.f}, aak = aab, arb = aab, ark = aab; float bon = 0.f;
#pragma unroll 1
        for (int s = 0; s < 2; ++s) {
            float r8[8], km8[8], kk8[8], b8[8], ld8[8];
#pragma unroll
            for (int ii = 0; ii < 2; ++ii) {
                const int i = 2 * s + ii;
                const f32x4 cw = lw[ii], ca = la[ii];
                const int chl = 16 * i + 4 * fq, ch = 64 * hd + chl;
                const f32x4 mur = *(const LAS f32x4*)(CT + ch), muk = *(const LAS f32x4*)(CT + 512 + ch), muv = *(const LAS f32x4*)(CT + 1024 + ch), w0 = *(const LAS f32x4*)(CT + 1536 + ch), a0 = *(const LAS f32x4*)(CT + 2048 + ch);
                const f32x4 k_k = *(const LAS f32x4*)(CT + 2560 + ch), k_a = *(const LAS f32x4*)(CT + 3072 + ch), r_k = *(const LAS f32x4*)(CT + 3584 + ch);
                float vv[4];
#pragma unroll
                for (int e = 0; e < 4; ++e) {
                    const float pr = (e & 1) ? bfhi(prc[ii][e >> 1]) : bflo(prc[ii][e >> 1]), prv = (e & 1) ? bfhi(prp[ii][e >> 1]) : bflo(prp[ii][e >> 1]);
                    const float pk = (e & 1) ? bfhi(pkc[ii][e >> 1]) : bflo(pkc[ii][e >> 1]), pkv = (e & 1) ? bfhi(pkp[ii][e >> 1]) : bflo(pkp[ii][e >> 1]);
                    const float pv = (e & 1) ? bfhi(pvc[ii][e >> 1]) : bflo(pvc[ii][e >> 1]), pvv = (e & 1) ? bfhi(pvp[ii][e >> 1]) : bflo(pvp[ii][e >> 1]);
                    const float r = pr + (prv - pr) * mur[e], k = pk + (pkv - pk) * muk[e]; vv[e] = pv + (pvv - pv) * muv[e];
                    const float z = w0[e] + cw[e];
                    const float sp = fmaxf(-z, 0.f) + __logf(1.f + __expf(-fabsf(z)));
                    const float wlog = -sp - 0.5f;
                    const float iclr = sigm_f(a0[e] + ca[e]);
                    const float kkn = k * k_k[e] * inv, km = k * (1.f + (iclr - 1.f) * k_a[e]);
                    r8[4 * ii + e] = r; km8[4 * ii + e] = km; kk8[4 * ii + e] = kkn; b8[4 * ii + e] = kkn * iclr; ld8[4 * ii + e] = -__expf(wlog);
                    bon += r * km * r_k[e];
                }
                *(u32x2*)(ops + OP_V + (chl >> 4) * 512 + fr * 32 + fq * 8) = (u32x2){pk2(vv[0], vv[1]), pk2(vv[2], vv[3])};
            }
            float rt[8], at[8], bt[8], kt[8], bh[8], kh[8], gcv[8];
#pragma unroll
            for (int j = 0; j < 8; ++j) {
                const float cum = prefix16(ld8[j]); const float tot = __shfl(cum, (lane & 48) | 15);
                const float e1 = __expf(cum), e2 = __expf(-cum), e3 = __expf(cum - ld8[j]), e4 = __expf(tot - cum);
                rt[j] = r8[j] * e1; at[j] = -kk8[j] * e3; bt[j] = b8[j] * e2; kt[j] = km8[j] * e2; bh[j] = b8[j] * e4; kh[j] = km8[j] * e4; gcv[j] = e1;
            }
            const bf16x8 RT = pack8(rt), AT = pack8(at), BT = pack8(bt), KT = pack8(kt);
            *(bf16x8*)(ops + OP_RP + ((s * 16 + fr) * 4 + fq) * 16) = RT;
#pragma unroll
            for (int ii = 0; ii < 2; ++ii) { const int chl = 16 * (2 * s + ii) + 4 * fq;
                *(LAS u32x2*)(AIMG + (fr * 64 + chl) * 2) = (u32x2){pk2(at[4 * ii], at[4 * ii + 1]), pk2(at[4 * ii + 2], at[4 * ii + 3])};
                *(u32x2*)(ops + OP_BH + (chl >> 4) * 512 + fr * 32 + fq * 8) = (u32x2){pk2(bh[4 * ii], bh[4 * ii + 1]), pk2(bh[4 * ii + 2], bh[4 * ii + 3])};
                *(u32x2*)(ops + OP_KH + (chl >> 4) * 512 + fr * 32 + fq * 8) = (u32x2){pk2(kh[4 * ii], kh[4 * ii + 1]), pk2(kh[4 * ii + 2], kh[4 * ii + 3])};
                if (fr == 15) *(f32x4*)(ops + OP_GC + chl * 4) = (f32x4){gcv[4 * ii], gcv[4 * ii + 1], gcv[4 * ii + 2], gcv[4 * ii + 3]}; }
            aab = __builtin_amdgcn_mfma_f32_16x16x32_bf16(AT, BT, aab, 0, 0, 0); aak = __builtin_amdgcn_mfma_f32_16x16x32_bf16(AT, KT, aak, 0, 0, 0);
            arb = __builtin_amdgcn_mfma_f32_16x16x32_bf16(RT, BT, arb, 0, 0, 0); ark = __builtin_amdgcn_mfma_f32_16x16x32_bf16(RT, KT, ark, 0, 0, 0);
#pragma unroll
            for (int ii = 0; ii < 2; ++ii) { lw[ii] = lw[2 + ii]; la[ii] = la[2 + ii]; prc[ii] = prc[2 + ii]; pkc[ii] = pkc[2 + ii]; pvc[ii] = pvc[2 + ii]; prp[ii] = prp[2 + ii]; pkp[ii] = pkp[2 + ii]; pvp[ii] = pvp[2 + ii]; }
        }
        bon += __shfl_xor(bon, 16); bon += __shfl_xor(bon, 32);
        if (fq == 0) *(float*)(ops + OP_BON + fr * 4) = bon;
#pragma unroll
        for (int e = 0; e < 4; ++e) { const int tq = 4 * fq + e; if (!(fr < tq)) { aab[e] = 0.f; aak[e] = 0.f; } if (!(fr <= tq)) { arb[e] = 0.f; ark[e] = 0.f; } }
        *(u32x2*)(ops + OP_ARBT + (fr * 16 + 4 * fq) * 2) = (u32x2){pk2(arb[0], arb[1]), pk2(arb[2], arb[3])};
        *(u32x2*)(ops + OP_ARKT + (fr * 16 + 4 * fq) * 2) = (u32x2){pk2(ark[0], ark[1]), pk2(ark[2], ark[3])};
        *(LAS f32x4*)(ATL + fr * 16 + 4 * fq) = aab;
        LDS_WAIT(); asm volatile("" ::: "memory");
        float x[16];
#pragma unroll
        for (int m = 0; m < 16; ++m) x[m] = (m == fr) ? 1.f : 0.f;
#pragma unroll
        for (int j = 14; j >= 0; --j) {
            float acc = x[j];
#pragma unroll
            for (int mq = (j + 1) / 4; mq < 4; ++mq) { const f32x4 col = *(const LAS f32x4*)(ATL + j * 16 + 4 * mq);
#pragma unroll
                for (int e = 0; e < 4; ++e) { const int m = 4 * mq + e; if (m > j) acc += x[m] * col[e]; } }
            x[j] = acc;
        }
        float xs[4];
#pragma unroll
        for (int e = 0; e < 4; ++e) xs[e] = (fq == 0) ? x[e] : (fq == 1) ? x[4 + e] : (fq == 2) ? x[8 + e] : x[12 + e];
        const bf16x8 xa = pack4z(xs[0], xs[1], xs[2], xs[3]);
        {   const f32x4 z4 = __builtin_amdgcn_mfma_f32_16x16x32_bf16(xa, pack4z(aak[0], aak[1], aak[2], aak[3]), (f32x4){0.f, 0.f, 0.f, 0.f}, 0, 0, 0);
            *(u32x2*)(ops + OP_ZT + (fr * 16 + 4 * fq) * 2) = (u32x2){pk2(z4[0], z4[1]), pk2(z4[2], z4[3])}; }
#pragma unroll
        for (int kt = 0; kt < 4; ++kt) {
            const s16x4 tr = vtr(AIMG + ((4 * fq + (fr >> 2)) * 64 + 16 * kt + 4 * (fr & 3)) * 2);
            const bf16x8 bw = (bf16x8){tr[0], tr[1], tr[2], tr[3], 0, 0, 0, 0};
            const f32x4 w4 = __builtin_amdgcn_mfma_f32_16x16x32_bf16(xa, bw, (f32x4){0.f, 0.f, 0.f, 0.f}, 0, 0, 0);
            *(u32x2*)(ops + OP_WT + ((16 * kt + fr) * 16 + 4 * fq) * 2) = (u32x2){pk2(w4[0], w4[1]), pk2(w4[2], w4[3])};
        }
        LDS_WAIT(); asm volatile("" ::: "memory");
        }
    }
}

constexpr int SC_NS = 9, SC_D = 7, SC_YB = SC_NS * OPS_STRIDE;
__device__ __forceinline__ void scan_unit(const Args& a, LAS unsigned char* lds, int bh) {
    const int tid = threadIdx.x, lane = tid & 63; const int wid = __builtin_amdgcn_readfirstlane(tid >> 6);
    const int b = bh >> 3, h = bh & 7;
    const unsigned char* ops_base = a.ws + WS_OPS + (size_t)bh * 256 * OPS_STRIDE;
    bf16_t* YIN = (bf16_t*)((unsigned char*)a.out + 64 * MiB);
    constexpr int NCH = SEQ / 16;
    asm volatile("s_waitcnt vmcnt(0) lgkmcnt(0)\n\ts_barrier" ::: "memory");
    if (wid == 4 || wid == 5) {
        const int pw = (wid - 4) * 7;
#define SC_ISSUE(c) do { const unsigned char* g_ = ops_base + (size_t)(c) * OPS_STRIDE + (pw * 1024) + lane * 16; const int so_ = ((c) % SC_NS) * OPS_STRIDE + pw * 1024; \
        _Pragma("unroll") for (int p_ = 0; p_ < 7; ++p_) __builtin_amdgcn_global_load_lds((const unsigned*)(g_ + p_ * 1024), (LAS unsigned*)(lds + so_ + p_ * 1024), 16, 0, 0); } while (0)
        for (int c = 0; c < SC_D; ++c) SC_ISSUE(c);
        for (int c = 0; c < NCH; ++c) {
            if (c <= NCH - SC_D) asm volatile("s_waitcnt vmcnt(35)\n\ts_barrier" ::: "memory"); else asm volatile("s_waitcnt vmcnt(0)\n\ts_barrier" ::: "memory");
            if (c + SC_D < NCH) SC_ISSUE(c + SC_D);
        }
        asm volatile("s_waitcnt vmcnt(0)\n\ts_barrier" ::: "memory");
        asm volatile("s_barrier" ::: "memory");
#undef SC_ISSUE
    } else if (wid < 4) {
        const int vl = lane & 15, g = lane >> 4, i4 = (lane & 15) >> 2, p4 = lane & 3;
        f32x4 st[4];
#pragma unroll
        for (int kt = 0; kt < 4; ++kt) st[kt] = (f32x4){0.f, 0.f, 0.f, 0.f};
        const int trw = ((4 * g + i4) * 16 + 4 * p4) * 2;
        const int trk = ((4 * g + i4) * 64 + 4 * p4) * 2;
#define SC_FDECL(X) bf16x8 X##wa0, X##wa1, X##rp0, X##rp1; s16x4 X##zt, X##vt, X##ab, X##ak, X##bh0, X##bh1, X##bh2, X##bh3, X##kh0, X##kh1, X##kh2, X##kh3; f32x4 X##gc0, X##gc1, X##gc2, X##gc3
#define SC_FLOAD(X, c_) do { const LAS unsigned char* sl_ = lds + ((c_) % SC_NS) * OPS_STRIDE; \
        { const s16x4 a_ = vtr(sl_ + OP_WT + trw), b_ = vtr(sl_ + OP_WT + 16 * 32 + trw); X##wa0 = (bf16x8){a_[0], a_[1], a_[2], a_[3], b_[0], b_[1], b_[2], b_[3]}; } \
        { const s16x4 a_ = vtr(sl_ + OP_WT + 32 * 32 + trw), b_ = vtr(sl_ + OP_WT + 48 * 32 + trw); X##wa1 = (bf16x8){a_[0], a_[1], a_[2], a_[3], b_[0], b_[1], b_[2], b_[3]}; } \
        X##rp0 = *(const LAS bf16x8*)(sl_ + OP_RP + ((0 * 16 + vl) * 4 + g) * 16); X##rp1 = *(const LAS bf16x8*)(sl_ + OP_RP + ((1 * 16 + vl) * 4 + g) * 16); \
        X##zt = vtr(sl_ + OP_ZT + trw); X##vt = vtr(sl_ + OP_V + trw + 512 * wid); X##ab = vtr(sl_ + OP_ARBT + trw); X##ak = vtr(sl_ + OP_ARKT + trw); \
        X##bh0 = vtr(sl_ + OP_BH + trw); X##bh1 = vtr(sl_ + OP_BH + trw + 512); X##bh2 = vtr(sl_ + OP_BH + trw + 1024); X##bh3 = vtr(sl_ + OP_BH + trw + 1536); \
        X##kh0 = vtr(sl_ + OP_KH + trw); X##kh1 = vtr(sl_ + OP_KH + trw + 512); X##kh2 = vtr(sl_ + OP_KH + trw + 1024); X##kh3 = vtr(sl_ + OP_KH + trw + 1536); \
        X##gc0 = *(const LAS f32x4*)(sl_ + OP_GC + (4 * g) * 4); X##gc1 = *(const LAS f32x4*)(sl_ + OP_GC + (16 + 4 * g) * 4); X##gc2 = *(const LAS f32x4*)(sl_ + OP_GC + (32 + 4 * g) * 4); X##gc3 = *(const LAS f32x4*)(sl_ + OP_GC + (48 + 4 * g) * 4); } while (0)
#define SC_STEP(X, c_) do { bf16x8 sb0_, sb1_; \
        { u32x4 w_ = (u32x4){pk2(st[0][0], st[0][1]), pk2(st[0][2], st[0][3]), pk2(st[1][0], st[1][1]), pk2(st[1][2], st[1][3])}; sb0_ = __builtin_bit_cast(bf16x8, w_); } \
        { u32x4 w_ = (u32x4){pk2(st[2][0], st[2][1]), pk2(st[2][2], st[2][3]), pk2(st[3][0], st[3][1]), pk2(st[3][2], st[3][3])}; sb1_ = __builtin_bit_cast(bf16x8, w_); } \
        f32x4 u_ = (f32x4){0.f, 0.f, 0.f, 0.f}, y_ = u_; \
        u_ = __builtin_amdgcn_mfma_f32_16x16x32_bf16(X##wa0, sb0_, u_, 0, 0, 0); u_ = __builtin_amdgcn_mfma_f32_16x16x32_bf16(X##wa1, sb1_, u_, 0, 0, 0); \
        u_ = __builtin_amdgcn_mfma_f32_16x16x32_bf16((bf16x8){X##zt[0], X##zt[1], X##zt[2], X##zt[3], 0, 0, 0, 0}, (bf16x8){X##vt[0], X##vt[1], X##vt[2], X##vt[3], 0, 0, 0, 0}, u_, 0, 0, 0); \
        y_ = __builtin_amdgcn_mfma_f32_16x16x32_bf16(X##rp0, sb0_, y_, 0, 0, 0); y_ = __builtin_amdgcn_mfma_f32_16x16x32_bf16(X##rp1, sb1_, y_, 0, 0, 0); \
        bf16x8 uv_; { u32x2 uw_ = (u32x2){pk2(u_[0], u_[1]), pk2(u_[2], u_[3])}; const s16x4 us_ = __builtin_bit_cast(s16x4, uw_); uv_ = (bf16x8){us_[0], us_[1], us_[2], us_[3], X##vt[0], X##vt[1], X##vt[2], X##vt[3]}; } \
        st[0] = __builtin_amdgcn_mfma_f32_16x16x32_bf16((bf16x8){X##bh0[0], X##bh0[1], X##bh0[2], X##bh0[3], X##kh0[0], X##kh0[1], X##kh0[2], X##kh0[3]}, uv_, st[0] * X##gc0, 0, 0, 0); \
        st[1] = __builtin_amdgcn_mfma_f32_16x16x32_bf16((bf16x8){X##bh1[0], X##bh1[1], X##bh1[2], X##bh1[3], X##kh1[0], X##kh1[1], X##kh1[2], X##kh1[3]}, uv_, st[1] * X##gc1, 0, 0, 0); \
        st[2] = __builtin_amdgcn_mfma_f32_16x16x32_bf16((bf16x8){X##bh2[0], X##bh2[1], X##bh2[2], X##bh2[3], X##kh2[0], X##kh2[1], X##kh2[2], X##kh2[3]}, uv_, st[2] * X##gc2, 0, 0, 0); \
        st[3] = __builtin_amdgcn_mfma_f32_16x16x32_bf16((bf16x8){X##bh3[0], X##bh3[1], X##bh3[2], X##bh3[3], X##kh3[0], X##kh3[1], X##kh3[2], X##kh3[3]}, uv_, st[3] * X##gc3, 0, 0, 0); \
        y_ = __builtin_amdgcn_mfma_f32_16x16x32_bf16((bf16x8){X##ab[0], X##ab[1], X##ab[2], X##ab[3], X##ak[0], X##ak[1], X##ak[2], X##ak[3]}, uv_, y_, 0, 0, 0); \
        LAS float* yb_ = (LAS float*)(lds + SC_YB + ((c_) & 1) * 4096) + 16 * wid + vl; \
        _Pragma("unroll") for (int e = 0; e < 4; ++e) yb_[(4 * g + e) * 64] = y_[e]; } while (0)
        SC_FDECL(fa_); SC_FDECL(fb_);
        for (int c = 0; c < NCH; c += 2) {
            asm volatile("s_waitcnt lgkmcnt(0)\n\ts_barrier" ::: "memory");
            if (c == 0) SC_FLOAD(fa_, 0);
            SC_FLOAD(fb_, c + 1);
            SC_STEP(fa_, c);
            asm volatile("s_waitcnt lgkmcnt(0)\n\ts_barrier" ::: "memory");
            if (c + 2 < NCH) SC_FLOAD(fa_, c + 2);
            SC_STEP(fb_, c + 1);
        }
#undef SC_FDECL
#undef SC_FLOAD
#undef SC_STEP
        asm volatile("s_waitcnt lgkmcnt(0)\n\ts_barrier" ::: "memory");
        asm volatile("s_barrier" ::: "memory");
    } else {
        const int pi = tid - 384, ptk = pi >> 3, pc8 = (pi & 7) * 8;
        const f32x4 lg0 = *(const f32x4*)(a.in[I_LNXG] + h * 64 + pc8), lg1 = *(const f32x4*)(a.in[I_LNXG] + h * 64 + pc8 + 4), lb0 = *(const f32x4*)(a.in[I_LNXB] + h * 64 + pc8), lb1 = *(const f32x4*)(a.in[I_LNXB] + h * 64 + pc8 + 4);
#define SC_POST(cc) do { const LAS unsigned char* sl_ = lds + ((cc) % SC_NS) * OPS_STRIDE; const LAS float* yb_ = (const LAS float*)(lds + SC_YB + ((cc) & 1) * 4096) + ptk * 64 + pc8; \
        const f32x4 y0_ = *(const LAS f32x4*)yb_, y1_ = *(const LAS f32x4*)(yb_ + 4); \
        const float mean_ = sum8(((y0_[0] + y0_[1]) + (y0_[2] + y0_[3])) + ((y1_[0] + y1_[1]) + (y1_[2] + y1_[3]))) * (1.f / 64.f); \
        const f32x4 d0_ = y0_ - mean_, d1_ = y1_ - mean_; \
        const float var_ = sum8(((d0_[0] * d0_[0] + d0_[1] * d0_[1]) + (d0_[2] * d0_[2] + d0_[3] * d0_[3])) + ((d1_[0] * d1_[0] + d1_[1] * d1_[1]) + (d1_[2] * d1_[2] + d1_[3] * d1_[3]))) * (1.f / 64.f); \
        const float rstd_ = 1.0f / sqrtf(var_ + LNX_EPS); \
        const u32x4 vw_ = *(const LAS u32x4*)(sl_ + OP_V + (pc8 >> 4) * 512 + ptk * 32 + (pc8 & 15) * 2), gw_ = *(const LAS u32x4*)(sl_ + OP_G + (pc8 >> 4) * 512 + ptk * 32 + (pc8 & 15) * 2); \
        const float bon_ = *(const LAS float*)(sl_ + OP_BON + ptk * 4); \
        const f32x4 v0_ = (f32x4){bflo(vw_[0]), bfhi(vw_[0]), bflo(vw_[1]), bfhi(vw_[1])}, v1_ = (f32x4){bflo(vw_[2]), bfhi(vw_[2]), bflo(vw_[3]), bfhi(vw_[3])}; \
        const f32x4 g0_ = (f32x4){bflo(gw_[0]), bfhi(gw_[0]), bflo(gw_[1]), bfhi(gw_[1])}, g1_ = (f32x4){bflo(gw_[2]), bfhi(gw_[2]), bflo(gw_[3]), bfhi(gw_[3])}; \
        const f32x4 o0_ = (d0_ * rstd_ * lg0 + lb0 + bon_ * v0_) * g0_, o1_ = (d1_ * rstd_ * lg1 + lb1 + bon_ * v1_) * g1_; \
        const size_t t_ = (size_t)b * SEQ + (size_t)(cc) * 16 + ptk; \
        *(u32x4*)(YIN + t_ * 1024 + 512 + h * 64 + pc8) = (u32x4){pk2(o0_[0], o0_[1]), pk2(o0_[2], o0_[3]), pk2(o1_[0], o1_[1]), pk2(o1_[2], o1_[3])}; } while (0)
        for (int c = 0; c < NCH; ++c) {
            asm volatile("s_waitcnt lgkmcnt(0)\n\ts_barrier" ::: "memory");
            if (c > 0) SC_POST(c - 1);
        }
        asm volatile("s_waitcnt lgkmcnt(0)\n\ts_barrier" ::: "memory");
        SC_POST(NCH - 1);
        asm volatile("s_waitcnt lgkmcnt(0)\n\ts_barrier" ::: "memory");
#undef SC_POST
    }
}

constexpr int AT_SLOT = 32768;
constexpr int AT_WSF = 4 * AT_SLOT;
constexpr int AT_XP = 132;
constexpr float AT_THR = 8.f;
#define MFMA16(A, B, C) __builtin_amdgcn_mfma_f32_16x16x32_bf16(A, B, C, 0, 0, 0)
__device__ __forceinline__ float max_over_rows(float m) {
    { auto r = __builtin_amdgcn_permlane16_swap(__float_as_uint(m), __float_as_uint(m), false, false); m = fmaxf(__uint_as_float(r[0]), __uint_as_float(r[1])); }
    { auto r = __builtin_amdgcn_permlane32_swap(__float_as_uint(m), __float_as_uint(m), false, false); m = fmaxf(__uint_as_float(r[0]), __uint_as_float(r[1])); }
    return m;
}
__device__ __forceinline__ void attn_unit(const Args& a, LAS unsigned char* lds, int b, int h, int u, float lam) {
    const int tid = threadIdx.x, lane = tid & 63, c16 = lane & 15, g = lane >> 4; const int wid = __builtin_amdgcn_readfirstlane(tid >> 6);
    const int comp = wid >> 2, wq = wid & 3;
    const bf16_t* PROJ = (const bf16_t*)(a.ws + WS_PROJ);
    bf16_t* YIN = (bf16_t*)((unsigned char*)a.out + 64 * MiB);
    const size_t rowbase = (size_t)b * SEQ; const int q0 = u * 128;
    const int NT = 2 * u + 2;
    const int ntw = (q0 + 32 * wq) / 64 + 1;
    LAS float* wsf = (LAS float*)(lds + AT_WSF) + wid * 64;
    const bf16_t* ksrc0 = PROJ + (rowbase + lane) * NPA + 512 + h * 128 + wid * 8;
    const bf16_t* vsrc0 = PROJ + (rowbase + 16 * (wid & 3) + (lane >> 2)) * NPA + 1024 + h * 128 + (wid >> 2) * 32 + (lane & 3) * 8;
#define AT_DMA(t) do { const size_t ro_ = (size_t)(t) * 64 * NPA; LAS unsigned char* S_ = lds + ((t) & 3) * AT_SLOT + wid * 1024; \
        __builtin_amdgcn_global_load_lds((const unsigned*)(ksrc0 + ro_), (LAS unsigned*)(S_), 16, 0, 0); \
        __builtin_amdgcn_global_load_lds((const unsigned*)(ksrc0 + ro_ + 64), (LAS unsigned*)(S_ + 8192), 16, 0, 0); \
        __builtin_amdgcn_global_load_lds((const unsigned*)(vsrc0 + ro_), (LAS unsigned*)(S_ + 16384), 16, 0, 0); \
        __builtin_amdgcn_global_load_lds((const unsigned*)(vsrc0 + ro_ + 64), (LAS unsigned*)(S_ + 16384 + 8192), 16, 0, 0); } while (0)
    asm volatile("s_waitcnt vmcnt(0) lgkmcnt(0)\n\ts_barrier" ::: "memory");
    const bf16_t* Qw = PROJ + (rowbase + q0 + 32 * wq + c16) * NPA + h * 128 + comp * 64 + 8 * g;
    bf16x8 qf[2][2];
#pragma unroll
    for (int rb = 0; rb < 2; ++rb)
#pragma unroll
        for (int s = 0; s < 2; ++s) qf[rb][s] = *(const bf16x8*)(Qw + (size_t)(16 * rb) * NPA + 32 * s);
    asm volatile("s_waitcnt vmcnt(0)" : "+v"(qf[0][0]), "+v"(qf[0][1]), "+v"(qf[1][0]), "+v"(qf[1][1]) :: "memory");
    AT_DMA(0);
    if (NT > 1) AT_DMA(1);
    if (NT > 2) AT_DMA(2);
    f32x4 o[2][8], lacc[2];
#pragma unroll
    for (int rb = 0; rb < 2; ++rb) { lacc[rb] = (f32x4){0.f, 0.f, 0.f, 0.f};
#pragma unroll
        for (int n = 0; n < 8; ++n) o[rb][n] = (f32x4){0.f, 0.f, 0.f, 0.f}; }
    float mhat[2] = {0.f, 0.f};
    const int qi0 = q0 + 32 * wq + c16;
    const int koff = comp * 8192 + g * 1024 + c16 * 16;
    const int voff = 16384 + (4 * g + (c16 >> 2)) * 64 + (c16 & 3) * 8;
    const bf16x8 ones = (bf16x8){0x3F80, 0x3F80, 0x3F80, 0x3F80, 0x3F80, 0x3F80, 0x3F80, 0x3F80};
    if (NT > 2) asm volatile("s_waitcnt vmcnt(8)\n\ts_barrier" ::: "memory"); else if (NT > 1) asm volatile("s_waitcnt vmcnt(4)\n\ts_barrier" ::: "memory"); else asm volatile("s_waitcnt vmcnt(0)\n\ts_barrier" ::: "memory");
    for (int t = 0; t < NT; ++t) {
        if (t + 3 < NT) AT_DMA(t + 3);
        if (t < ntw) {
            const LAS unsigned char* Kb = lds + (t & 3) * AT_SLOT + koff;
            const LAS unsigned char* Vb = lds + (t & 3) * AT_SLOT + voff;
            f32x4 st[2][4];
#pragma unroll
            for (int rb = 0; rb < 2; ++rb)
#pragma unroll
                for (int kt = 0; kt < 4; ++kt) st[rb][kt] = (f32x4){-mhat[rb], -mhat[rb], -mhat[rb], -mhat[rb]};
#pragma unroll
            for (int s = 0; s < 2; ++s)
#pragma unroll
                for (int kt = 0; kt < 4; ++kt) { const bf16x8 kf = *(const LAS bf16x8*)(Kb + s * 4096 + kt * 256);
                    st[0][kt] = MFMA16(kf, qf[0][s], st[0][kt]); st[1][kt] = MFMA16(kf, qf[1][s], st[1][kt]); }
            const int kv0 = t * 64;
            if (kv0 + 63 > q0 + 32 * wq) {
#pragma unroll
                for (int kt = 0; kt < 4; ++kt)
#pragma unroll
                    for (int e = 0; e < 4; ++e) { const int kv = kv0 + 16 * kt + 4 * g + e; if (kv > qi0) st[0][kt][e] = -INFINITY; if (kv > qi0 + 16) st[1][kt][e] = -INFINITY; }
            }
            float rm[2];
#pragma unroll
            for (int rb = 0; rb < 2; ++rb) { float m = fmaxf(fmaxf(st[rb][0][0], st[rb][0][1]), fmaxf(st[rb][0][2], st[rb][0][3]));
#pragma unroll
                for (int kt = 1; kt < 4; ++kt) m = fmaxf(fmaxf(m, st[rb][kt][0]), fmaxf(fmaxf(st[rb][kt][1], st[rb][kt][2]), st[rb][kt][3]));
                rm[rb] = max_over_rows(m); }
            if (t == 0 || __any(fmaxf(rm[0], rm[1]) > AT_THR)) {
#pragma unroll
                for (int rb = 0; rb < 2; ++rb) {
                    const float dl = (t == 0) ? rm[rb] : fmaxf(rm[rb], 0.f);
                    mhat[rb] += dl;
#pragma unroll
                    for (int kt = 0; kt < 4; ++kt) st[rb][kt] = st[rb][kt] - dl;
                    if (g == 0) wsf[16 * rb + c16] = __builtin_amdgcn_exp2f(-dl);
                }
                if (t != 0) {
                    LDS_WAIT();
#pragma unroll
                    for (int rb = 0; rb < 2; ++rb) { const f32x4 f4 = *(const LAS f32x4*)(wsf + 16 * rb + 4 * g);
                        lacc[rb] = lacc[rb] * f4;
#pragma unroll
                        for (int n = 0; n < 8; ++n) o[rb][n] = o[rb][n] * f4; }
                }
                LDS_WAIT();
            }
            bf16x8 pa[2][2];
#pragma unroll
            for (int rb = 0; rb < 2; ++rb) {
#pragma unroll
                for (int kt = 0; kt < 4; ++kt)
#pragma unroll
                    for (int e = 0; e < 4; ++e) st[rb][kt][e] = __builtin_amdgcn_exp2f(st[rb][kt][e]);
#pragma unroll
                for (int sp = 0; sp < 2; ++sp) { const f32x4 x0 = st[rb][2 * sp], x1 = st[rb][2 * sp + 1];
                    u32x4 w = (u32x4){pk2(x0[0], x0[1]), pk2(x0[2], x0[3]), pk2(x1[0], x1[1]), pk2(x1[2], x1[3])}; pa[rb][sp] = __builtin_bit_cast(bf16x8, w); }
            }
#pragma unroll
            for (int rb = 0; rb < 2; ++rb)
#pragma unroll
                for (int sp = 0; sp < 2; ++sp) lacc[rb] = MFMA16(pa[rb][sp], ones, lacc[rb]);
#pragma unroll
            for (int n = 0; n < 8; ++n)
#pragma unroll
                for (int sp = 0; sp < 2; ++sp) {
                    const LAS unsigned char* vp = Vb + (n >> 1) * 4096 + (n & 1) * 32 + sp * 2048;
                    const s16x4 lo = vtr(vp), hv = vtr(vp + 1024);
                    const bf16x8 vf = (bf16x8){lo[0], lo[1], lo[2], lo[3], hv[0], hv[1], hv[2], hv[3]};
                    o[0][n] = MFMA16(pa[0][sp], vf, o[0][n]); o[1][n] = MFMA16(pa[1][sp], vf, o[1][n]);
                }
        }
        if (t + 3 < NT) asm volatile("s_waitcnt vmcnt(8) lgkmcnt(0)\n\ts_barrier" ::: "memory");
        else if (t + 2 < NT) asm volatile("s_waitcnt vmcnt(4) lgkmcnt(0)\n\ts_barrier" ::: "memory");
        else asm volatile("s_waitcnt vmcnt(0) lgkmcnt(0)\n\ts_barrier" ::: "memory");
    }
    LAS float* Xt = (LAS float*)lds + wq * (32 * AT_XP);
    if (comp == 1) {
#pragma unroll
        for (int rb = 0; rb < 2; ++rb)
#pragma unroll
            for (int e = 0; e < 4; ++e) { const float rl = 1.0f / lacc[rb][e];
#pragma unroll
                for (int n = 0; n < 8; ++n) Xt[(16 * rb + 4 * g + e) * AT_XP + 16 * n + c16] = o[rb][n][e] * rl; }
    }
    __syncthreads();
    if (comp == 0) {
#pragma unroll
        for (int rb = 0; rb < 2; ++rb)
#pragma unroll
            for (int e = 0; e < 4; ++e) { const float rl = 1.0f / lacc[rb][e];
#pragma unroll
                for (int n = 0; n < 8; ++n) { LAS float* p = Xt + (16 * rb + 4 * g + e) * AT_XP + 16 * n + c16; *p = o[rb][n][e] * rl - lam * (*p); } }
        LDS_WAIT(); asm volatile("" ::: "memory");
        const int row = lane >> 1, half = lane & 1;
        const LAS float* rp = Xt + row * AT_XP + half * 64;
        f32x4 v[16]; float ss = 0.f;
#pragma unroll
        for (int i = 0; i < 16; ++i) { v[i] = *(const LAS f32x4*)(rp + 4 * i); ss += (v[i][0] * v[i][0] + v[i][1] * v[i][1]) + (v[i][2] * v[i][2] + v[i][3] * v[i][3]); }
        ss += __shfl_xor(ss, 1);
        const float rstd = 0.8f / sqrtf(ss * (1.f / 128.f) + SUBLN_EPS);
        const float* sg = a.in[I_SUBLN] + half * 64;
        bf16_t* op = YIN + (rowbase + q0 + 32 * wq + row) * 1024 + h * 128 + half * 64;
#pragma unroll
        for (int i = 0; i < 8; ++i) { const f32x4 g0 = *(const f32x4*)(sg + 8 * i), g1 = *(const f32x4*)(sg + 8 * i + 4); const f32x4 x0 = v[2 * i] * rstd * g0, x1 = v[2 * i + 1] * rstd * g1;
            *(u32x4*)(op + 8 * i) = (u32x4){pk2(x0[0], x0[1]), pk2(x0[2], x0[3]), pk2(x1[0], x1[1]), pk2(x1[2], x1[3])}; }
    }
    __syncthreads();
#undef AT_DMA
}
#undef MFMA16

__device__ __forceinline__ void phase4(const Args& a, LAS unsigned char* lds) {
    const int tid = threadIdx.x;
    if (!(a.flags & 1)) for (int bh = blockIdx.x; bh < 64; bh += gridDim.x) scan_unit(a, lds, bh);
    if (a.flags & 2) return;
    float lam;
    { const int l = tid & 63; const float s1 = wave_sum(a.in[I_LQ1][l] * a.in[I_LK1][l]), s2 = wave_sum(a.in[I_LQ2][l] * a.in[I_LK2][l]); lam = __expf(s1) - __expf(s2) + 0.2f; }
    unsigned* ctl = (unsigned*)(a.ws + WS_CTL);
    LAS unsigned* qslot = (LAS unsigned*)(lds + 147456 - 64);
    for (;;) {
        __syncthreads();
        if (tid == 0) *qslot = atomicAdd(ctl + CW_QUEUE, 1u);
        __syncthreads();
        const unsigned idx = *qslot;
        if (idx >= 1024u) break;
        const int u = 31 - (int)(idx >> 5), bh = (int)(idx & 31);
        attn_unit(a, lds, bh >> 2, bh & 3, u, lam);
    }
}

__device__ __forceinline__ void phase6(const Args& a, LAS unsigned char* lds) {
    const int tid = threadIdx.x, lane = tid & 63, wid = __builtin_amdgcn_readfirstlane(tid >> 6);
    LAS float* cG = (LAS float*)lds; LAS float* cA = cG + 1024; LAS float* cB = cA + 1024;
    const bf16_t* YM = (const bf16_t*)(a.ws + WS_YMIX); const float* SSQ = (const float*)(a.ws + WS_SSQ1);
    bf16_t* H2 = (bf16_t*)(a.ws + WS_H2);
    for (int rb = blockIdx.x; rb < TOK / 128; rb += gridDim.x) {
        const int b = rb / 32;
        __syncthreads();
        for (int j = tid; j < 1024; j += NTHREADS) { cG[j] = ada_val(a, b, 2048 + j) * a.in[I_GPOSTMIX][j]; cA[j] = a.in[I_GPREFFN][j] * (1.f + ada_val(a, b, 4096 + j)); cB[j] = ada_val(a, b, 3072 + j); }
        __syncthreads();
        for (int rr = wid; rr < 128; rr += 2 * NWAVES) {
            const size_t row0 = (size_t)rb * 128 + rr;
            f32x4 xv[2][4]; u32x2 yv[2][4]; float sq[2];
#pragma unroll
            for (int q = 0; q < 2; ++q) { const size_t row = row0 + q * NWAVES; sq[q] = (lane < 16) ? SSQ[row * 16 + lane] : 0.f;
                const f32x4* xr = (const f32x4*)(a.in[I_X] + row * DM) + lane; const u32x2* yr = (const u32x2*)(YM + row * DM) + lane;
#pragma unroll
                for (int j = 0; j < 4; ++j) { xv[q][j] = __builtin_nontemporal_load(xr + 64 * j); yv[q][j] = __builtin_nontemporal_load(yr + 64 * j); } }
#pragma unroll
            for (int q = 0; q < 2; ++q) { const size_t row = row0 + q * NWAVES;
                const float rstd0 = 1.0f / sqrtf(wave_sum(sq[q]) * (1.f / DM) + RMS_EPS);
                f32x4 v[4]; float s = 0.f;
#pragma unroll
                for (int j = 0; j < 4; ++j) { const u32x2 yw = yv[q][j]; const f32x4 y = (f32x4){bflo(yw[0]), bfhi(yw[0]), bflo(yw[1]), bfhi(yw[1])};
                    const f32x4 g = *(const LAS f32x4*)(cG + 4 * lane + 256 * j);
                    v[j] = xv[q][j] + g * y * rstd0; s += (v[j].x * v[j].x + v[j].y * v[j].y) + (v[j].z * v[j].z + v[j].w * v[j].w); }
                const float rstd = 1.0f / sqrtf(wave_sum(s) * (1.f / DM) + RMS_EPS);
                unsigned long long* o8 = (unsigned long long*)(H2 + row * DM) + lane;
#pragma unroll
                for (int j = 0; j < 4; ++j) {
                    const f32x4 ca = *(const LAS f32x4*)(cA + 4 * lane + 256 * j), cb = *(const LAS f32x4*)(cB + 4 * lane + 256 * j);
                    const f32x4 hh = v[j] * rstd * ca + cb;
                    o8[64 * j] = (unsigned long long)pk2(hh.x, hh.y) | ((unsigned long long)pk2(hh.z, hh.w) << 32); }
            }
        }
    }
}
__device__ __forceinline__ void phase9(const Args& a, LAS unsigned char* lds) {
    const int tid = threadIdx.x, lane = tid & 63, wid = __builtin_amdgcn_readfirstlane(tid >> 6);
    LAS float* cG = (LAS float*)lds; LAS float* cM = cG + 1024;
    const bf16_t* FF = (const bf16_t*)(a.ws + WS_F); const float* SSQ = (const float*)(a.ws + WS_SSQ2);
    const bf16_t* YM = (const bf16_t*)(a.ws + WS_YMIX); const float* SSQ1 = (const float*)(a.ws + WS_SSQ1);
    for (int rb = blockIdx.x; rb < TOK / 128; rb += gridDim.x) {
        const int b = rb / 32;
        __syncthreads();
        for (int j = tid; j < 1024; j += NTHREADS) { cG[j] = ada_val(a, b, 5120 + j) * a.in[I_GPOSTFFN][j]; cM[j] = ada_val(a, b, 2048 + j) * a.in[I_GPOSTMIX][j]; }
        __syncthreads();
        for (int rr = wid; rr < 128; rr += 2 * NWAVES) {
            const size_t row0 = (size_t)rb * 128 + rr;
            f32x4 xv[2][4]; u32x2 yv[2][4], mv[2][4]; float sq[2], sm[2];
#pragma unroll
            for (int q = 0; q < 2; ++q) { const size_t row = row0 + q * NWAVES; sq[q] = (lane < 16) ? SSQ[row * 16 + lane] : 0.f; sm[q] = (lane < 16) ? SSQ1[row * 16 + lane] : 0.f;
                const f32x4* xr = (const f32x4*)(a.in[I_X] + row * DM) + lane; const u32x2* yr = (const u32x2*)(FF + row * DM) + lane; const u32x2* mr = (const u32x2*)(YM + row * DM) + lane;
#pragma unroll
                for (int j = 0; j < 4; ++j) { xv[q][j] = __builtin_nontemporal_load(xr + 64 * j); yv[q][j] = __builtin_nontemporal_load(yr + 64 * j); mv[q][j] = __builtin_nontemporal_load(mr + 64 * j); } }
#pragma unroll
            for (int q = 0; q < 2; ++q) { const size_t row = row0 + q * NWAVES;
                const float rstd0 = 1.0f / sqrtf(wave_sum(sq[q]) * (1.f / DM) + RMS_EPS), rstdm = 1.0f / sqrtf(wave_sum(sm[q]) * (1.f / DM) + RMS_EPS);
                f32x4* orow = (f32x4*)(a.out + row * DM) + lane;
#pragma unroll
                for (int j = 0; j < 4; ++j) { const u32x2 yw = yv[q][j], mw = mv[q][j];
                    const f32x4 y = (f32x4){bflo(yw[0]), bfhi(yw[0]), bflo(yw[1]), bfhi(yw[1])}, m = (f32x4){bflo(mw[0]), bfhi(mw[0]), bflo(mw[1]), bfhi(mw[1])};
                    const f32x4 g = *(const LAS f32x4*)(cG + 4 * lane + 256 * j), gm = *(const LAS f32x4*)(cM + 4 * lane + 256 * j);
                    const f32x4 x1 = xv[q][j] + gm * m * rstdm;
                    __builtin_nontemporal_store(x1 + g * y * rstd0, orow + 64 * j); }
            }
        }
    }
}

#define XB_TMO      128
#define XB_XCNT(j)  (256  + 64 * (j))
#define XB_XSUB(j)  (1280 + 64 * (j))
#define XB_XGEN(j)  (2304 + 64 * (j))
#define XB_TOP      3328
#define XB_TOPGEN   3392
#define XCD_BAR_WORDS 3456
#define XB_SPIN_CAP (1u << 18)
__device__ __forceinline__ unsigned xb_ld(unsigned* p)              { return __hip_atomic_load(p, __ATOMIC_RELAXED, __HIP_MEMORY_SCOPE_AGENT); }
__device__ __forceinline__ unsigned xb_add(unsigned* p, unsigned v) { return __hip_atomic_fetch_add(p, v, __ATOMIC_RELAXED, __HIP_MEMORY_SCOPE_AGENT); }
__device__ __forceinline__ unsigned xb_xcc_id() { return (unsigned)__builtin_amdgcn_s_getreg((3 << 11) | 20) & 0xFu; }
#define XB_SPIN(cond, bar) do { unsigned _sp = 0; while (cond) { __builtin_amdgcn_s_sleep(1); \
    if ((++_sp & 255u) == 0u) { if (xb_ld(&(bar)[XB_TMO])) break; if (_sp > XB_SPIN_CAP) { atomicAdd(&(bar)[XB_TMO], 1u); break; } } } } while (0)
struct XcdBarrier { unsigned* bar; unsigned x; volatile LAS unsigned* st; };
__device__ __forceinline__ XcdBarrier xcd_barrier_post(unsigned* bar, volatile LAS unsigned* st) {
    XcdBarrier b; b.bar = bar; b.x = xb_xcc_id(); b.st = st;
    if (threadIdx.x == 0) (void)xb_add(&bar[XB_XCNT(b.x)], 1u);
    return b;
}
__device__ __forceinline__ void xcd_barrier_complete(unsigned* bar, unsigned x, unsigned& nloc, unsigned& nx) {
    const unsigned G = gridDim.x * gridDim.y * gridDim.z;
    unsigned sum, cnt, mine, sp = 0u;
    for (;;) {
        sum = 0u; cnt = 0u; mine = 0u;
#pragma unroll
        for (unsigned j = 0; j < 16; ++j) { const unsigned c = xb_ld(&bar[XB_XCNT(j)]); sum += c; cnt += (c > 0u) ? 1u : 0u; mine = (j == x) ? c : mine; }
        if (sum == G) break;
        __builtin_amdgcn_s_sleep(1);
        if ((++sp & 255u) == 0u) { if (xb_ld(&bar[XB_TMO])) break; if (sp > XB_SPIN_CAP) { atomicAdd(&bar[XB_TMO], 1u); break; } }
    }
    nloc = mine > 0u ? mine : 1u; nx = cnt > 0u ? cnt : 1u;
}
__device__ __forceinline__ void xcd_barrier(const XcdBarrier& b) {
    asm volatile("s_waitcnt vmcnt(0)" ::: "memory");
    __syncthreads();
    if (threadIdx.x == 0) {
        unsigned* bar = b.bar;
        __builtin_amdgcn_s_waitcnt(0);
        unsigned nloc = b.st[0], nx = b.st[1];
        if (nloc == 0u) { xcd_barrier_complete(bar, b.x, nloc, nx); b.st[0] = nloc; b.st[1] = nx; }
        const unsigned old = xb_add(&bar[XB_XSUB(b.x)], 1u);
        const unsigned gen = old / nloc;
        if (old + 1u == (gen + 1u) * nloc) {
            __builtin_amdgcn_fence(__ATOMIC_RELEASE, "agent");
            asm volatile("s_waitcnt vmcnt(0)" ::: "memory");
            const unsigned og = xb_add(&bar[XB_TOP], 1u);
            const unsigned tg = og / nx;
            if (og + 1u == (tg + 1u) * nx) xb_add(&bar[XB_TOPGEN], 1u);
            else XB_SPIN(xb_ld(&bar[XB_TOPGEN]) == tg, bar);
            __builtin_amdgcn_fence(__ATOMIC_ACQUIRE, "agent");
            xb_add(&bar[XB_XGEN(b.x)], 1u);
            asm volatile("s_waitcnt vmcnt(0)" ::: "memory");
        } else {
            XB_SPIN(xb_ld(&bar[XB_XGEN(b.x)]) == gen, bar);
            __builtin_amdgcn_fence(__ATOMIC_ACQUIRE, "agent");
            asm volatile("s_waitcnt vmcnt(0)" ::: "memory");
        }
    }
    __syncthreads();
}

constexpr int NPHASE = 10;
__global__ void __launch_bounds__(NTHREADS, 2) fwd(Args args) {
    extern __shared__ __attribute__((aligned(16))) unsigned char lds_raw[];
    LAS unsigned char* lds = (LAS unsigned char*)lds_raw;
    const int lo = args.ph_lo, hi = args.ph_hi;
    unsigned char* ws = args.ws;
    volatile LAS unsigned* bst = (volatile LAS unsigned*)(lds + LDS_BYTES - 32);
    if (threadIdx.x < 2) bst[threadIdx.x] = 0u;
    __syncthreads();
    XcdBarrier bar; bar.bar = (unsigned*)(ws + WS_CTL) + CW_BAR; bar.x = 0; bar.st = bst;
    if (hi - lo > 1) bar = xcd_barrier_post((unsigned*)(ws + WS_CTL) + CW_BAR, bst);
#define SEAM(k) do { if (IN(k) && IN((k) + 1)) { xcd_barrier(bar); } } while (0)
#ifndef PHMASK
#define PHMASK 0x3ff
#endif
#define IN(k) ((PHMASK >> (k) & 1) && lo <= (k) && (k) < hi)
    if (IN(0)) { phase0(args, lds); } SEAM(0);
    if (IN(1)) { phase1(args, lds); } SEAM(1);
    if (IN(2)) {
        pg8::Gemm g{(const bf16_t*)args.out, (const bf16_t*)(ws + WS_WEXT), TOK, NPROJ, DM}; pg8::StaticOrder S; S.init(TOK, NPROJ, gridDim.x, blockIdx.x);
        pg8::EpiProj E{(bf16_t*)(ws + WS_PROJ), (bf16_t*)(ws + WS_PROJR), C2};
        pg8::gemm_phase<pg8::EpiProj, pg8::StaticOrder, true, true>(lds, g, S, E);
    } SEAM(2);
    if (IN(3)) { phase3(args, lds); } SEAM(3);
    if (IN(4)) { phase4(args, lds); } SEAM(4);
    if (IN(5)) {
        pg8::Gemm g{(const bf16_t*)((unsigned char*)args.out + 64 * MiB), (const bf16_t*)(ws + WS_WOUT), TOK, DM, DM}; pg8::StaticOrder S; S.init(TOK, DM, gridDim.x, blockIdx.x);
        pg8::EpiBf16Ssq E{(bf16_t*)(ws + WS_YMIX), DM, (float*)(ws + WS_SSQ1)};
        pg8::gemm_phase<pg8::EpiBf16Ssq, pg8::StaticOrder, true, true>(lds, g, S, E);
    } SEAM(5);
    if (IN(6)) { phase6(args, lds); } SEAM(6);
    if (IN(7)) {
        pg8::Gemm g{(const bf16_t*)(ws + WS_H2), (const bf16_t*)(ws + WS_WGU), TOK, 2 * FFH, DM}; pg8::StaticOrder S; S.init(TOK, 2 * FFH, gridDim.x, blockIdx.x);
        pg8::EpiSwiGlu E{(bf16_t*)(ws + WS_HID), FFH};
        pg8::gemm_phase<pg8::EpiSwiGlu, pg8::StaticOrder, true, true>(lds, g, S, E);
    } SEAM(7);
    if (IN(8)) {
        pg8::Gemm g{(const bf16_t*)(ws + WS_HID), (const bf16_t*)(ws + WS_WDN), TOK, DM, FFH}; pg8::StaticOrder S; S.init(TOK, DM, gridDim.x, blockIdx.x);
        pg8::EpiBf16Ssq E{(bf16_t*)(ws + WS_F), DM, (float*)(ws + WS_SSQ2)};
        pg8::gemm_phase<pg8::EpiBf16Ssq, pg8::StaticOrder, true, true>(lds, g, S, E);
    } SEAM(8);
    if (IN(9)) { phase9(args, lds); }
#undef IN
#undef SEAM
}

extern "C" void kernel_launch(void* const* d_in, const int* in_sizes, int n_in, void* d_out, int out_size, void* d_ws, size_t ws_size, hipStream_t stream) {
    static int grid = 0;
    if (grid == 0) {
        if (n_in != 37 || out_size != TOK * DM || ws_size < WS_END) { fprintf(stderr, "kernel_launch: unexpected shapes (n_in %d out %d ws %zu)\n", n_in, out_size, ws_size); grid = -1; return; }
        int dev = 0, cus = 0, per_cu = 0;
        hipGetDevice(&dev); hipDeviceGetAttribute(&cus, hipDeviceAttributeMultiprocessorCount, dev);
        hipFuncSetAttribute((const void*)fwd, hipFuncAttributeMaxDynamicSharedMemorySize, LDS_BYTES);
        hipOccupancyMaxActiveBlocksPerMultiprocessor(&per_cu, (const void*)fwd, NTHREADS, LDS_BYTES);
        (void)hipGetLastError();
        if (per_cu < 1) { fprintf(stderr, "kernel_launch: occupancy query says %d blocks per CU\n", per_cu); per_cu = 1; }
        grid = cus;
        fprintf(stderr, "kernel_launch: cus %d per_cu %d grid %d ws %zu\n", cus, per_cu, grid, ws_size);
    }
    if (grid < 0) return;
    hipMemsetAsync((char*)d_ws + WS_CTL, 0, CTL_ZERO_BYTES, stream);
    Args a{};
    for (int i = 0; i < 37; ++i) a.in[i] = (const float*)d_in[i];
    a.out = (float*)d_out; a.ws = (unsigned char*)d_ws;
#if defined(PROBE_DOUBLE)
    for (int p = 0; p < NPHASE; ++p) { a.ph_lo = p; a.ph_hi = p + 1; a.flags = 0; hipLaunchKernelGGL(fwd, dim3(grid), dim3(NTHREADS), LDS_BYTES, stream, a);
        if ((PROBE_DOUBLE >> p) & 1) { if (p == 4) { hipMemsetAsync((char*)d_ws + WS_CTL, 0, CTL_ZERO_BYTES, stream); a.flags = PROBE_P4FLAGS; }
            hipLaunchKernelGGL(fwd, dim3(grid), dim3(NTHREADS), LDS_BYTES, stream, a); } }
#elif N_LAUNCH_MODE == 1
    a.ph_lo = 0; a.ph_hi = NPHASE;
    void* kargs[] = {&a};
    hipError_t e = hipLaunchCooperativeKernel((const void*)fwd, dim3(grid), dim3(NTHREADS), kargs, LDS_BYTES, stream);
    if (e != hipSuccess) fprintf(stderr, "cooperative launch failed: %s (grid %d)\n", hipGetErrorString(e), grid);
#else
    for (int p = 0; p < NPHASE; ++p) { a.ph_lo = p; a.ph_hi = p + 1; hipLaunchKernelGGL(fwd, dim3(grid), dim3(NTHREADS), LDS_BYTES, stream, a); }
#endif
}
```

```cpp
#include <hip/hip_runtime.h>
#include <hip/hip_cooperative_groups.h>
#include <cstdio>
#include <cstdint>
namespace cg = cooperative_groups;

#ifndef PROBE_P4FLAGS
#define PROBE_P4FLAGS 0
#endif
#ifndef N_LAUNCH_MODE
#define N_LAUNCH_MODE 1
#endif

#define LAS __attribute__((address_space(3)))
typedef unsigned short bf16_t;
typedef short bf16x8 __attribute__((ext_vector_type(8)));
typedef short s16x4 __attribute__((ext_vector_type(4)));
typedef float f32x2 __attribute__((ext_vector_type(2)));
typedef float f32x4 __attribute__((ext_vector_type(4)));
typedef float f32x16 __attribute__((ext_vector_type(16)));
typedef unsigned u32x2 __attribute__((ext_vector_type(2)));
typedef unsigned u32x4 __attribute__((ext_vector_type(4)));
typedef __bf16 bf16x2_t __attribute__((ext_vector_type(2)));

constexpr int NB = 8, SEQ = 4096, DM = 1024, TOK = NB * SEQ;
constexpr int NPROJ = 3584;
constexpr int NPA = 1536;
constexpr int FFH = 2816;
constexpr int NTHREADS = 512, NWAVES = 8;
constexpr int LDS_BYTES = 147456;
constexpr float C2 = 0.125f * 1.4426950408889634f;
constexpr float RMS_EPS = 1e-6f, SUBLN_EPS = 1e-5f, LNX_EPS = 64e-5f;

constexpr size_t MiB = 1u << 20;
constexpr size_t WS_CTL = 0, CTL_ZERO_BYTES = 64 * 1024;
constexpr size_t WS_WEXT = 1 * MiB;
constexpr size_t WS_WOUT = 8 * MiB;
constexpr size_t WS_WGU = 10 * MiB;
constexpr size_t WS_WDN = 21 * MiB;
constexpr size_t WS_W2T = 27 * MiB;
constexpr size_t WS_A2T = WS_W2T + 65536;
constexpr size_t WS_G2T = WS_A2T + 65536;
constexpr size_t WS_ADAP = 28 * MiB;
constexpr size_t WS_SSQ1 = 31 * MiB - 0;
constexpr size_t WS_BONUS = 33 * MiB;
constexpr size_t WS_SSQ2 = 34 * MiB;
constexpr size_t WS_PROJ = 36 * MiB;
constexpr size_t WS_PROJR = WS_PROJ + (size_t)32768 * 1536 * 2;
constexpr size_t WS_H2 = WS_PROJ;
constexpr size_t WS_F = WS_PROJ + 64 * MiB;
constexpr size_t WS_SCAN = 260 * MiB;
constexpr size_t WS_YMIX = WS_SCAN;
constexpr size_t WS_HID = WS_SCAN + 64 * MiB;
constexpr size_t WS_END = 500 * MiB;
constexpr size_t WS_OPS = WS_SCAN;
constexpr int OPS_STRIDE = 14336;
constexpr int OP_RP = 0, OP_WT = 2048, OP_ZT = 4096, OP_ARBT = 4608, OP_ARKT = 5120, OP_BH = 5632, OP_KH = 7680, OP_V = 9728, OP_G = 11776, OP_GC = 13824, OP_BON = 14080;

constexpr int CW_QUEUE = 0;
constexpr int CW_BAR = 4096;

__device__ __forceinline__ unsigned pk2(float lo, float hi) { f32x2 v = {lo, hi}; bf16x2_t b = __builtin_convertvector(v, bf16x2_t); return __builtin_bit_cast(unsigned, b); }
__device__ __forceinline__ float bf2f(unsigned short h) { return __uint_as_float(((unsigned)h) << 16); }
__device__ __forceinline__ float bflo(unsigned w) { return __uint_as_float(w << 16); }
__device__ __forceinline__ float bfhi(unsigned w) { return __uint_as_float(w & 0xffff0000u); }
#define LDS_WAIT() asm volatile("s_waitcnt lgkmcnt(0)" ::: "memory")

namespace pg8 {
constexpr int BM = 256, BK = 64, HALF = 128, HTB = HALF * BK * 2, STAGE_BYTES = 8 * HTB, NXCD = 8, WGM = 8;
__host__ __device__ __forceinline__ int lds_byte(int r, int c) { const int st = (r >> 4) * 2 + (c >> 5), rr = r & 15, cc = c & 31, ob = rr * 64 + cc * 2; return st * 1024 + (ob ^ (((ob >> 9) & 1) << 5)); }
__host__ __device__ __forceinline__ void stage_rc(int b, int& R, int& C) { const int st = b / 1024, sb = b % 1024, swz = sb ^ (((sb >> 9) & 1) << 5); R = (st >> 1) * 16 + swz / 64; C = (st & 1) * 32 + (swz % 64) / 2; }
__host__ __device__ __forceinline__ int perm32(int rho) { const int n = rho >> 4, i = rho & 15; return 8 * (i >> 2) + 4 * n + (i & 3); }
struct Unit { int pm, pn; };
struct Gemm { const bf16_t* A; const bf16_t* Bt; int M, N, K; };
struct StaticOrder {
    int nM, nN, nwg, G, c;
    __host__ __device__ void init(int M, int N, int G_, int c_) { nM = M / BM; nN = N / BM; nwg = nM * nN; G = G_; c = c_; }
    __host__ __device__ bool next(int i, Unit& u) const {
        const long L = (long)i * G + c; if (L >= nwg) return false;
        int wgid = (int)L; { const int q = nwg / NXCD, r = nwg % NXCD, xcd = wgid % NXCD, off = wgid / NXCD; wgid = (xcd < r ? xcd * (q + 1) : r * (q + 1) + (xcd - r) * q) + off; }
        const int nig = WGM * nN, gid = wgid / nig, fm = gid * WGM, gsz = (nM - fm) < WGM ? (nM - fm) : WGM;
        u.pm = fm + ((wgid % nig) % gsz); u.pn = (wgid % nig) / gsz; return true;
    }
    __device__ __forceinline__ void a_ready(const Unit&) const {}
    __device__ __forceinline__ void done(const Unit&) const {}
};
struct EpiProj {
    static constexpr bool PERM = true, AFTER_DRAIN = false;
    bf16_t* A; bf16_t* R; float scale0;
    __device__ __forceinline__ void operator()(const f32x4 (&acc)[2][2][4][2], const Unit& u, int wr, int wc, int fr, int fq) const {
        const int row0 = u.pm * BM + wr * 64 + fr; const int col0 = u.pn * BM + wc * 32 + 8 * fq;
        const float sc = (u.pn < 2) ? scale0 : 1.f; const bool att = (u.pn < 6);
#pragma unroll
        for (int ai = 0; ai < 2; ++ai)
#pragma unroll
            for (int m = 0; m < 4; ++m) { const int row = row0 + ai * HALF + m * 16;
#pragma unroll
                for (int bj = 0; bj < 2; ++bj) { const f32x4 v0 = acc[ai][bj][m][0] * sc, v1 = acc[ai][bj][m][1] * sc; const int col = col0 + bj * HALF;
                    u32x4 w; w.x = pk2(v0[0], v0[1]); w.y = pk2(v0[2], v0[3]); w.z = pk2(v1[0], v1[1]); w.w = pk2(v1[2], v1[3]);
                    bf16_t* dst;
                    if (u.pn < 2) dst = A + (size_t)row * 512 + col;
                    else if (att) { const int kc = col - 512; const int hh = (kc >> 7) & 3;
                        bf16_t* T = A + (size_t)TOK * 512 + ((size_t)((row >> 12) * 4 + hh) * 64 + ((row >> 6) & 63)) * 16384; const int r = row & 63;
                        dst = (u.pn < 4) ? T + (((kc >> 6) & 1) * 8 + ((kc >> 3) & 7)) * 512 + r * 8
                                         : T + 8192 + ((kc >> 5) & 3) * 2048 + r * 32 + (kc & 31); }
                    else dst = R + ((size_t)(row >> 4) * 128 + ((col - 1536) >> 4)) * 256 + (row & 15) * 16 + (col & 15);
                    *(u32x4*)dst = w; } }
    }
};
struct EpiBf16Ssq {
    static constexpr bool PERM = true, AFTER_DRAIN = false;
    bf16_t* O; int ldc; float* ssq;
    __device__ __forceinline__ void operator()(const f32x4 (&acc)[2][2][4][2], const Unit& u, int wr, int wc, int fr, int fq) const {
        const int row0 = u.pm * BM + wr * 64 + fr; const int col0 = u.pn * BM + wc * 32 + 8 * fq;
#pragma unroll
        for (int ai = 0; ai < 2; ++ai)
#pragma unroll
            for (int m = 0; m < 4; ++m) { const int row = row0 + ai * HALF + m * 16; bf16_t* rowp = O + (size_t)row * ldc + col0; float s = 0.f;
#pragma unroll
                for (int bj = 0; bj < 2; ++bj) { const f32x4 v0 = acc[ai][bj][m][0], v1 = acc[ai][bj][m][1];
                    s += (v0[0] * v0[0] + v0[1] * v0[1]) + (v0[2] * v0[2] + v0[3] * v0[3]) + (v1[0] * v1[0] + v1[1] * v1[1]) + (v1[2] * v1[2] + v1[3] * v1[3]);
                    u32x4 w; w.x = pk2(v0[0], v0[1]); w.y = pk2(v0[2], v0[3]); w.z = pk2(v1[0], v1[1]); w.w = pk2(v1[2], v1[3]);
                    *(u32x4*)(rowp + bj * HALF) = w; }
                s += __shfl_xor(s, 16); s += __shfl_xor(s, 32);
                if (fq == 0) ssq[(size_t)row * 16 + u.pn * 4 + wc] = s; }
    }
};
struct EpiSwiGlu {
    static constexpr bool PERM = true, AFTER_DRAIN = false;
    bf16_t* O; int ldc;
    __device__ __forceinline__ void operator()(const f32x4 (&acc)[2][2][4][2], const Unit& u, int wr, int wc, int fr, int fq) const {
        const int row0 = u.pm * BM + wr * 64 + fr; const int col0 = u.pn * HALF + wc * 32 + 8 * fq;
#pragma unroll
        for (int ai = 0; ai < 2; ++ai)
#pragma unroll
            for (int m = 0; m < 4; ++m) { bf16_t* rowp = O + (size_t)(row0 + ai * HALF + m * 16) * ldc + col0; float h[8];
#pragma unroll
                for (int n = 0; n < 2; ++n)
#pragma unroll
                    for (int e = 0; e < 4; ++e) { const float g = acc[ai][0][m][n][e], up = acc[ai][1][m][n][e];
                        const float sg = g * __builtin_amdgcn_rcpf(1.f + __builtin_amdgcn_exp2f(-1.4426950408889634f * g)); h[n * 4 + e] = sg * up; }
                u32x4 w; w.x = pk2(h[0], h[1]); w.y = pk2(h[2], h[3]); w.z = pk2(h[4], h[5]); w.w = pk2(h[6], h[7]);
                *(u32x4*)rowp = w; }
    }
};

template <class Epi, class Sched, bool ALIGN_EPI = false, bool SP2 = false>
__device__ __forceinline__ void gemm_phase(LAS unsigned char* lds, const Gemm g, const Sched& S, const Epi& E) {
    const int tid = threadIdx.x, wid = __builtin_amdgcn_readfirstlane(tid >> 6), lane = tid & 63, wr = wid >> 2, wc = wid & 3, fr = lane & 15, fq = lane >> 4;
    const int K = g.K, nt = K / BK;
    unsigned voffA[2], voffB[2];
#pragma unroll
    for (int i = 0; i < 2; ++i) { int R, C; stage_rc(tid * 16 + i * 8192, R, C); const int Rb = Epi::PERM ? ((R & ~31) + perm32(R & 31)) : R;
        voffA[i] = (unsigned)(R * K + C) * 2u; voffB[i] = (unsigned)(Rb * K + C) * 2u; }
    const size_t kstep = (size_t)(BK * 2);
    const size_t hstep = (size_t)HALF * K * 2;
    const size_t tstep = 2 * hstep;
    const unsigned ldsw = (unsigned)wid * 1024u;
    const int aoff = lds_byte(wr * 64 + fr, fq * 8), boff = lds_byte(wc * 32 + fr, fq * 8);
#define PG8_SA(b, h) (((b) * 2 + (h)) * HTB)
#define PG8_SB(b, h) ((4 + (b) * 2 + (h)) * HTB)
#define PG8_STAGE(bufoff, gbase, voff) do { _Pragma("unroll") for (int _i = 0; _i < 2; ++_i) \
        __builtin_amdgcn_global_load_lds((const unsigned*)((const char*)(gbase) + (voff)[_i]), (LAS unsigned*)(lds + (bufoff) + ldsw + _i * 8192), 16, 0, 0); } while (0)
#define PG8_LDA(dst, b, h) do { _Pragma("unroll") for (int m = 0; m < 4; ++m) _Pragma("unroll") for (int k = 0; k < 2; ++k) dst[m][k] = *(const LAS bf16x8*)(lds + PG8_SA(b, h) + aoff + m * 2048 + k * 1024); } while (0)
#define PG8_LDB(dst, b, h) do { _Pragma("unroll") for (int n = 0; n < 2; ++n) _Pragma("unroll") for (int k = 0; k < 2; ++k) dst[n][k] = *(const LAS bf16x8*)(lds + PG8_SB(b, h) + boff + n * 2048 + k * 1024); } while (0)
#define PG8_MMA(ai, bj, At, Bt) do { __builtin_amdgcn_s_setprio(1); _Pragma("unroll") for (int m = 0; m < 4; ++m) _Pragma("unroll") for (int n = 0; n < 2; ++n) _Pragma("unroll") for (int k = 0; k < 2; ++k) \
        acc[ai][bj][m][n] = __builtin_amdgcn_mfma_f32_16x16x32_bf16(Bt[n][k], At[m][k], acc[ai][bj][m][n], 0, 0, 0); __builtin_amdgcn_s_setprio(0); } while (0)
#define PG8_WAIT_V(n) asm volatile("s_waitcnt vmcnt(" #n ")" ::: "memory")
#define PG8_WAIT_L(n) asm volatile("s_waitcnt lgkmcnt(" #n ")" ::: "memory")
#define PG8_BAR __builtin_amdgcn_s_barrier()
#define PG8_SCHED __builtin_amdgcn_sched_barrier(0)
    Unit cur, nxt; int ui = 0;
    if (!S.next(0, cur)) return;
    f32x4 acc[2][2][4][2];
#pragma unroll
    for (int a = 0; a < 2; ++a)
#pragma unroll
        for (int b = 0; b < 2; ++b)
#pragma unroll
            for (int m = 0; m < 4; ++m)
#pragma unroll
                for (int n = 0; n < 2; ++n) acc[a][b][m][n] = (f32x4){0.f, 0.f, 0.f, 0.f};
    bf16x8 At[4][2], B0[2][2], B1[2][2];
    const char* cA = (const char*)g.A + (size_t)cur.pm * tstep; const char* cB = (const char*)g.Bt + (size_t)cur.pn * tstep;
    S.a_ready(cur);
    if constexpr (SP2) {
        PG8_STAGE(PG8_SB(0, 0), cB, voffB); PG8_STAGE(PG8_SB(0, 1), cB + hstep, voffB); PG8_STAGE(PG8_SA(0, 0), cA, voffA); PG8_STAGE(PG8_SA(0, 1), cA + hstep, voffA);
        if (wr == 1) PG8_BAR;
        PG8_WAIT_V(2); PG8_BAR;
        PG8_STAGE(PG8_SB(1, 0), cB + kstep, voffB); PG8_STAGE(PG8_SA(1, 0), cA + kstep, voffA); PG8_STAGE(PG8_SB(1, 1), cB + hstep + kstep, voffB);
        PG8_WAIT_V(6); PG8_BAR;
    } else {
        PG8_STAGE(PG8_SB(0, 0), cB, voffB); PG8_STAGE(PG8_SA(0, 0), cA, voffA); PG8_STAGE(PG8_SB(0, 1), cB + hstep, voffB); PG8_STAGE(PG8_SA(0, 1), cA + hstep, voffA);
        if (wr == 1) PG8_BAR;
        PG8_WAIT_V(4); PG8_BAR;
        PG8_STAGE(PG8_SB(1, 0), cB + kstep, voffB); PG8_STAGE(PG8_SA(1, 0), cA + kstep, voffA); PG8_STAGE(PG8_SB(1, 1), cB + hstep + kstep, voffB);
        PG8_WAIT_V(6); PG8_BAR;
    }
    for (;;) {
        const bool has_next = S.next(ui + 1, nxt);
        const char* nA = has_next ? (const char*)g.A + (size_t)nxt.pm * tstep : cA; const char* nB = has_next ? (const char*)g.Bt + (size_t)nxt.pn * tstep : cB;
        for (int t = 0; t < nt; t += 2) {
            const bool last = (t == nt - 2);
            const char* a1 = cA + (size_t)(t + 1) * kstep;
            const char* a2 = last ? nA : cA + (size_t)(t + 2) * kstep; const char* b2 = last ? nB : cB + (size_t)(t + 2) * kstep;
            const char* a3 = a2 + kstep; const char* b3 = b2 + kstep;
            if (last && has_next) S.a_ready(nxt);
            if constexpr (SP2) {
            PG8_LDB(B0, 0, 0); PG8_LDB(B1, 0, 1); PG8_SCHED; PG8_LDA(At, 0, 0); PG8_STAGE(PG8_SA(1, 1), a1 + hstep, voffA);
            PG8_WAIT_V(8); PG8_WAIT_L(0); PG8_BAR; PG8_MMA(0, 0, At, B0); PG8_MMA(0, 1, At, B1); PG8_BAR; PG8_SCHED;
            PG8_LDA(At, 0, 1); PG8_STAGE(PG8_SB(0, 0), b2, voffB); PG8_STAGE(PG8_SB(0, 1), b2 + hstep, voffB); PG8_STAGE(PG8_SA(0, 0), a2, voffA);
            PG8_WAIT_V(8); PG8_WAIT_L(0); PG8_BAR; PG8_MMA(1, 0, At, B0); PG8_MMA(1, 1, At, B1); PG8_BAR; PG8_SCHED;
            PG8_LDB(B0, 1, 0); PG8_LDB(B1, 1, 1); PG8_SCHED; PG8_LDA(At, 1, 0); PG8_STAGE(PG8_SA(0, 1), a2 + hstep, voffA);
            PG8_WAIT_V(8); PG8_WAIT_L(0); PG8_BAR; PG8_MMA(0, 0, At, B0); PG8_MMA(0, 1, At, B1); PG8_BAR; PG8_SCHED;
            PG8_LDA(At, 1, 1); PG8_STAGE(PG8_SB(1, 0), b3, voffB); PG8_STAGE(PG8_SB(1, 1), b3 + hstep, voffB); PG8_STAGE(PG8_SA(1, 0), a3, voffA);
            PG8_WAIT_V(8); PG8_WAIT_L(0); PG8_BAR; PG8_MMA(1, 0, At, B0); PG8_MMA(1, 1, At, B1); PG8_BAR; PG8_SCHED;
            } else {
            PG8_LDB(B0, 0, 0); PG8_SCHED; PG8_LDA(At, 0, 0); PG8_STAGE(PG8_SA(1, 1), a1 + hstep, voffA);
            PG8_WAIT_L(8); PG8_BAR; PG8_WAIT_L(0); PG8_MMA(0, 0, At, B0); PG8_BAR; PG8_SCHED;
            PG8_LDB(B1, 0, 1); PG8_STAGE(PG8_SB(0, 0), b2, voffB);
            PG8_BAR; PG8_WAIT_L(0); PG8_MMA(0, 1, At, B1); PG8_BAR;
            PG8_LDA(At, 0, 1); PG8_STAGE(PG8_SA(0, 0), a2, voffA);
            PG8_BAR; PG8_WAIT_L(0); PG8_MMA(1, 0, At, B0); PG8_BAR; PG8_SCHED;
            PG8_STAGE(PG8_SB(0, 1), b2 + hstep, voffB);
            PG8_WAIT_V(6); PG8_BAR; PG8_MMA(1, 1, At, B1); PG8_BAR;
            PG8_LDB(B0, 1, 0); PG8_SCHED; PG8_LDA(At, 1, 0); PG8_STAGE(PG8_SA(0, 1), a2 + hstep, voffA);
            PG8_WAIT_L(8); PG8_BAR; PG8_WAIT_L(0); PG8_MMA(0, 0, At, B0); PG8_BAR; PG8_SCHED;
            PG8_LDB(B1, 1, 1); PG8_STAGE(PG8_SB(1, 0), b3, voffB);
            PG8_BAR; PG8_WAIT_L(0); PG8_MMA(0, 1, At, B1); PG8_BAR;
            PG8_LDA(At, 1, 1); PG8_STAGE(PG8_SA(1, 0), a3, voffA);
            PG8_BAR; PG8_WAIT_L(0); PG8_MMA(1, 0, At, B0); PG8_BAR; PG8_SCHED;
            PG8_STAGE(PG8_SB(1, 1), b3 + hstep, voffB);
            PG8_WAIT_V(6); PG8_BAR; PG8_MMA(1, 1, At, B1); PG8_BAR;
            }
        }
        if constexpr (ALIGN_EPI) { if (wr == 0) PG8_BAR; }
        if constexpr (!Epi::AFTER_DRAIN) { E(acc, cur, wr, wc, fr, fq); S.done(cur); }
        if (!has_next) break;
#pragma unroll
        for (int a = 0; a < 2; ++a)
#pragma unroll
            for (int b = 0; b < 2; ++b)
#pragma unroll
                for (int m = 0; m < 4; ++m)
#pragma unroll
                    for (int n = 0; n < 2; ++n) acc[a][b][m][n] = (f32x4){0.f, 0.f, 0.f, 0.f};
        cur = nxt; cA = nA; cB = nB; ++ui;
        if constexpr (ALIGN_EPI) { if (wr == 1) PG8_BAR; }
    }
    PG8_WAIT_V(0);
    if constexpr (!ALIGN_EPI) { if (wr == 0) PG8_BAR; }
    PG8_BAR;
#undef PG8_SA
#undef PG8_SB
#undef PG8_STAGE
#undef PG8_LDA
#undef PG8_LDB
#undef PG8_MMA
#undef PG8_WAIT_V
#undef PG8_WAIT_L
#undef PG8_BAR
#undef PG8_SCHED
}
}

struct Args {
    const float* in[37];
    float* out;
    unsigned char* ws;
    int ph_lo, ph_hi, flags, pad;
};
enum { I_X = 0, I_C, I_WADA, I_BADA, I_GPREMIX, I_GPOSTMIX, I_GPREFFN, I_GPOSTFFN, I_WIN, I_LQ1, I_LK1, I_LQ2, I_LK2, I_SUBLN, I_MUR, I_MUK, I_MUV, I_MUW, I_MUA, I_MUG,
       I_W0, I_W1, I_W2, I_A0, I_A1, I_A2, I_G1, I_G2, I_KK, I_KA, I_RK, I_LNXG, I_LNXB, I_WOUT, I_WGATE, I_WUP, I_WDOWN };

__device__ __forceinline__ const bf16_t* projr(const bf16_t* PR, int t, int colr) { return PR + ((size_t)(t >> 4) * 128 + (colr >> 4)) * 256 + (t & 15) * 16 + (colr & 15); }
__device__ __forceinline__ float wave_sum(float v) {
#pragma unroll
    for (int o = 1; o < 64; o <<= 1) v += __shfl_xor(v, o);
    return v;
}
template <int CTRL> __device__ __forceinline__ float dppf(float x) { return __builtin_bit_cast(float, __builtin_amdgcn_update_dpp(0, __builtin_bit_cast(int, x), CTRL, 0xf, 0xf, true)); }
__device__ __forceinline__ float sum8(float v) { v += dppf<0xB1>(v); v += dppf<0x4E>(v); v += dppf<0x141>(v); return v; }
__device__ __forceinline__ float sum16(float v) { v = sum8(v); v += dppf<0x140>(v); return v; }

__device__ __forceinline__ void tr_item(const float* W, int K, int N, bf16_t* WT, int ldo, int dst_row0, LAS float* scr, int kb, int nb, int lane, const float* mu, int mode) {
    const int k0 = 64 * kb, n0 = 32 * nb;
#pragma unroll 8
    for (int i = 0; i < 32; ++i) { const int kk = 2 * i + (lane >> 5); float v = W[(size_t)(k0 + kk) * N + n0 + (lane & 31)];
        if (mode == 1) v *= (1.f - mu[k0 + kk]); else if (mode == 2) v *= mu[k0 + kk];
        scr[kk * 33 + (lane & 31)] = v; }
    LDS_WAIT(); asm volatile("" ::: "memory");
    const int c = lane & 7;
#pragma unroll
    for (int j = 0; j < 4; ++j) { const int n = (lane >> 3) + 8 * j; const LAS float* s = scr + (8 * c) * 33 + n;
        u32x4 o; o.x = pk2(s[0 * 33], s[1 * 33]); o.y = pk2(s[2 * 33], s[3 * 33]); o.z = pk2(s[4 * 33], s[5 * 33]); o.w = pk2(s[6 * 33], s[7 * 33]);
        *(u32x4*)(WT + (size_t)(dst_row0 + n) * ldo + k0 + 8 * c) = o; }
    LDS_WAIT(); asm volatile("" ::: "memory");
}

__device__ __forceinline__ void phase0(const Args& a, LAS unsigned char* lds) {
    const int tid = threadIdx.x, lane = tid & 63, wid = __builtin_amdgcn_readfirstlane(tid >> 6);
    const int G = gridDim.x;
    LAS float* scr = (LAS float*)(lds + wid * 8704);
    unsigned char* ws = a.ws;
    bf16_t* Wext = (bf16_t*)(ws + WS_WEXT); bf16_t* Wout = (bf16_t*)(ws + WS_WOUT); bf16_t* Wgu = (bf16_t*)(ws + WS_WGU); bf16_t* Wdn = (bf16_t*)(ws + WS_WDN);
    bf16_t* W2t = (bf16_t*)(ws + WS_W2T); bf16_t* A2t = (bf16_t*)(ws + WS_A2T); bf16_t* G2t = (bf16_t*)(ws + WS_G2T);
    const int gw = blockIdx.x * NWAVES + wid, NGW = G * NWAVES;
    constexpr int J0 = 1536, J1 = 32, J5 = 64, J7 = 512, J8 = 1408, J11 = 16, J13 = 32;
    constexpr int NITEMS = J0 + 4 * J1 + 2 * J5 + J7 + 3 * J8 + 2 * J11 + J13;
    for (int it = gw; it < NITEMS; it += NGW) {
        int r = it;
        if (r < J0) { tr_item(a.in[I_WIN], 1024, 3072, Wext, 1024, (r % 96) * 32, scr, r / 96, r % 96, lane, nullptr, 0); continue; } r -= J0;
        if (r < J1) { tr_item(a.in[I_W1], 1024, 64, Wext, 1024, 3072 + (r % 2) * 32, scr, r / 2, r % 2, lane, a.in[I_MUW], 1); continue; } r -= J1;
        if (r < J1) { tr_item(a.in[I_W1], 1024, 64, Wext, 1024, 3136 + (r % 2) * 32, scr, r / 2, r % 2, lane, a.in[I_MUW], 2); continue; } r -= J1;
        if (r < J1) { tr_item(a.in[I_A1], 1024, 64, Wext, 1024, 3200 + (r % 2) * 32, scr, r / 2, r % 2, lane, a.in[I_MUA], 1); continue; } r -= J1;
        if (r < J1) { tr_item(a.in[I_A1], 1024, 64, Wext, 1024, 3264 + (r % 2) * 32, scr, r / 2, r % 2, lane, a.in[I_MUA], 2); continue; } r -= J1;
        if (r < J5) { tr_item(a.in[I_G1], 1024, 128, Wext, 1024, 3328 + (r % 4) * 32, scr, r / 4, r % 4, lane, a.in[I_MUG], 1); continue; } r -= J5;
        if (r < J5) { tr_item(a.in[I_G1], 1024, 128, Wext, 1024, 3456 + (r % 4) * 32, scr, r / 4, r % 4, lane, a.in[I_MUG], 2); continue; } r -= J5;
        if (r < J7) { tr_item(a.in[I_WOUT], 1024, 1024, Wout, 1024, (r % 32) * 32, scr, r / 32, r % 32, lane, nullptr, 0); continue; } r -= J7;
        if (r < J8) { const int nb = r % 88, n0 = nb * 32; tr_item(a.in[I_WGATE], 1024, 2816, Wgu, 1024, 256 * (n0 / 128) + (n0 % 128), scr, r / 88, nb, lane, nullptr, 0); continue; } r -= J8;
        if (r < J8) { const int nb = r % 88, n0 = nb * 32; tr_item(a.in[I_WUP], 1024, 2816, Wgu, 1024, 256 * (n0 / 128) + (n0 % 128) + 128, scr, r / 88, nb, lane, nullptr, 0); continue; } r -= J8;
        if (r < J8) { tr_item(a.in[I_WDOWN], 2816, 1024, Wdn, 2816, (r % 32) * 32, scr, r / 32, r % 32, lane, nullptr, 0); continue; } r -= J8;
        if (r < J11) { tr_item(a.in[I_W2], 64, 512, W2t, 64, r * 32, scr, 0, r, lane, nullptr, 0); continue; } r -= J11;
        if (r < J11) { tr_item(a.in[I_A2], 64, 512, A2t, 64, r * 32, scr, 0, r, lane, nullptr, 0); continue; } r -= J11;
        tr_item(a.in[I_G2], 128, 512, G2t, 128, (r % 16) * 32, scr, r / 16, r % 16, lane, nullptr, 0);
    }
    LAS float* sc = (LAS float*)(lds + 73728);
    const float* cin = a.in[I_C];
    for (int i = tid; i < 8192; i += NTHREADS) { const float v = cin[i]; sc[i] = v * __builtin_amdgcn_rcpf(1.f + __expf(-v)); }
    __syncthreads();
    float* adap = (float*)(ws + WS_ADAP); const float* wada = a.in[I_WADA];
    for (int it = blockIdx.x * NTHREADS + tid; it < 16 * 6144; it += G * NTHREADS) {
        const int col = it % 6144, kc = it / 6144; float acc[8];
#pragma unroll
        for (int b = 0; b < 8; ++b) acc[b] = 0.f;
        for (int k = kc * 64; k < kc * 64 + 64; ++k) { const float w = wada[(size_t)k * 6144 + col];
#pragma unroll
            for (int b = 0; b < 8; ++b) acc[b] += sc[b * 1024 + k] * w; }
#pragma unroll
        for (int b = 0; b < 8; ++b) adap[(size_t)(kc * 8 + b) * 6144 + col] = acc[b];
    }
    __syncthreads();
}
__device__ __forceinline__ float ada_val(const Args& a, int b, int j) {
    const float* adap = (const float*)(a.ws + WS_ADAP); float s = a.in[I_BADA][j];
#pragma unroll
    for (int kc = 0; kc < 16; ++kc) s += adap[(size_t)(kc * 8 + b) * 6144 + j];
    return s;
}

__device__ __forceinline__ void phase1(const Args& a, LAS unsigned char* lds) {
    const int tid = threadIdx.x, lane = tid & 63, wid = __builtin_amdgcn_readfirstlane(tid >> 6);
    LAS float* cA = (LAS float*)lds; LAS float* cB = cA + 1024;
    bf16_t* H1 = (bf16_t*)a.out;
    for (int rb = blockIdx.x; rb < TOK / 128; rb += gridDim.x) {
        const int b = rb / 32;
        __syncthreads();
        for (int j = tid; j < 1024; j += NTHREADS) { cA[j] = a.in[I_GPREMIX][j] * (1.f + ada_val(a, b, 1024 + j)); cB[j] = ada_val(a, b, j); }
        __syncthreads();
        for (int rr = wid; rr < 128; rr += 2 * NWAVES) {
            const size_t row0 = (size_t)rb * 128 + rr;
            f32x4 v[2][4]; float s[2] = {0.f, 0.f};
#pragma unroll
            for (int q = 0; q < 2; ++q) { const f32x4* xr = (const f32x4*)(a.in[I_X] + (row0 + q * NWAVES) * DM) + lane;
#pragma unroll
                for (int j = 0; j < 4; ++j) v[q][j] = __builtin_nontemporal_load(xr + 64 * j); }
#pragma unroll
            for (int q = 0; q < 2; ++q) {
#pragma unroll
                for (int j = 0; j < 4; ++j) s[q] += (v[q][j].x * v[q][j].x + v[q][j].y * v[q][j].y) + (v[q][j].z * v[q][j].z + v[q][j].w * v[q][j].w);
                const float rstd = 1.0f / sqrtf(wave_sum(s[q]) * (1.f / DM) + RMS_EPS);
                unsigned long long* o8 = (unsigned long long*)(H1 + (row0 + q * NWAVES) * DM) + lane;
#pragma unroll
                for (int j = 0; j < 4; ++j) { const f32x4 ca = *(const LAS f32x4*)(cA + 4 * lane + 256 * j), cb = *(const LAS f32x4*)(cB + 4 * lane + 256 * j);
                    const f32x4 h = v[q][j] * rstd * ca + cb;
                    o8[64 * j] = (unsigned long long)pk2(h.x, h.y) | ((unsigned long long)pk2(h.z, h.w) << 32); }
            }
        }
    }
}

__device__ __forceinline__ float tanh_f(float x) { const float e = __expf(2.f * x); return 1.f - 2.f * __builtin_amdgcn_rcpf(e + 1.f); }
__device__ __forceinline__ float sigm_f(float x) { return __builtin_amdgcn_rcpf(1.f + __expf(-x)); }
typedef short v4i16_t __attribute__((ext_vector_type(4)));
__device__ __forceinline__ s16x4 vtr(const LAS unsigned char* p) { return __builtin_bit_cast(s16x4, __builtin_amdgcn_ds_read_tr16_b64_v4i16((LAS v4i16_t*)p)); }
__device__ __forceinline__ float prefix16(float x) { x += dppf<0x111>(x); x += dppf<0x112>(x); x += dppf<0x114>(x); x += dppf<0x118>(x); return x; }
__device__ __forceinline__ bf16x8 pack8(const float* v) { u32x4 w = (u32x4){pk2(v[0], v[1]), pk2(v[2], v[3]), pk2(v[4], v[5]), pk2(v[6], v[7])}; return __builtin_bit_cast(bf16x8, w); }
__device__ __forceinline__ bf16x8 pack4z(float a, float b, float c, float d) { u32x4 w = (u32x4){pk2(a, b), pk2(c, d), 0u, 0u}; return __builtin_bit_cast(bf16x8, w); }
__device__ __forceinline__ void phase3(const Args& a, LAS unsigned char* lds) {
    const int tid = threadIdx.x, lane = tid & 63, wid = __builtin_amdgcn_readfirstlane(tid >> 6);
    const bf16_t* PR = (const bf16_t*)(a.ws + WS_PROJR);
    const bf16_t* W2t = (const bf16_t*)(a.ws + WS_W2T); const bf16_t* A2t = (const bf16_t*)(a.ws + WS_A2T); const bf16_t* G2t = (const bf16_t*)(a.ws + WS_G2T);
    constexpr int XP = 264;
    LAS bf16_t* Xs = (LAS bf16_t*)(lds + wid * 8448);
    LAS unsigned char* AIMG = lds + 67584 + wid * 3072;
    LAS float* ATL = (LAS float*)(AIMG + 2048);
    const int fr = lane & 15, fq = lane >> 4;
    LAS float* CT = (LAS float*)(lds + 92160);
    { const int ch = tid;
      CT[ch] = a.in[I_MUR][ch]; CT[512 + ch] = a.in[I_MUK][ch]; CT[1024 + ch] = a.in[I_MUV][ch]; CT[1536 + ch] = a.in[I_W0][ch];
      CT[2048 + ch] = a.in[I_A0][ch]; CT[2560 + ch] = a.in[I_KK][ch]; CT[3072 + ch] = a.in[I_KA][ch]; CT[3584 + ch] = a.in[I_RK][ch]; }
    LAS unsigned char* WB = lds + 108544;
    const unsigned char* wsrc[4];
#pragma unroll
    for (int q = 0; q < 4; ++q) { const int pz = wid * 4 + q;
        if (pz < 16) { const int row = 8 * (pz & 7) + (lane >> 3), pc = lane & 7, lc = pc ^ ((row >> 1) & 7);
            wsrc[q] = (const unsigned char*)((pz < 8) ? W2t : A2t) + row * 128 + lc * 16; }
        else { const int row = 4 * (pz - 16) + (lane >> 4), pc = lane & 15, lc = pc ^ (row & 15);
            wsrc[q] = (const unsigned char*)G2t + row * 256 + lc * 16; } }
    const int whs = (wid < 4) ? 8192 : 16384;
#define P3_WDMA(hd_) do { _Pragma("unroll") for (int q_ = 0; q_ < 4; ++q_) \
        __builtin_amdgcn_global_load_lds((const unsigned*)(wsrc[q_] + (size_t)(hd_) * whs), (LAS unsigned*)(WB + (wid * 4 + q_) * 1024), 16, 0, 0); } while (0)
    __syncthreads();
    for (int tt = blockIdx.x * NWAVES + wid; tt < TOK / 16; tt += gridDim.x * NWAVES) {
        const int t0 = tt * 16;
        P3_WDMA(0);
        {
            const int xtok = lane >> 2, xp = lane & 3; const int tx = t0 + xtok; const bool hp = (tx % SEQ) != 0;
            const int txp = tx - (hp ? 1 : 0);
#pragma unroll
            for (int jb = 0; jb < 2; ++jb) {
                u32x4 cw4[4], pw4[4];
#pragma unroll
                for (int jj = 0; jj < 4; ++jj) { const int j = 4 * jb + jj, j8 = (xp + 4 * j) * 8;
                    const int ccur = (j < 2) ? 3072 + j8 : (j < 4) ? 3200 + (j8 - 64) : 3328 + (j8 - 128), cprev = (j < 2) ? 3136 + j8 : (j < 4) ? 3264 + (j8 - 64) : 3456 + (j8 - 128);
                    cw4[jj] = *(const u32x4*)projr(PR, tx, ccur - 1536); pw4[jj] = *(const u32x4*)projr(PR, txp, cprev - 1536); if (!hp) pw4[jj] = (u32x4){0u, 0u, 0u, 0u}; }
#pragma unroll
                for (int jj = 0; jj < 4; ++jj) { const int j = 4 * jb + jj, j8 = (xp + 4 * j) * 8; unsigned o[4];
#pragma unroll
                    for (int i = 0; i < 4; ++i) { float lo = bflo(cw4[jj][i]) + bflo(pw4[jj][i]), hi = bfhi(cw4[jj][i]) + bfhi(pw4[jj][i]);
                        if (j < 2) { lo = tanh_f(lo); hi = tanh_f(hi); } else if (j >= 4) { lo = sigm_f(lo); hi = sigm_f(hi); }
                        o[i] = pk2(lo, hi); }
                    *(LAS u32x4*)(Xs + xtok * XP + j8) = (u32x4){o[0], o[1], o[2], o[3]}; }
            }
        }
        LDS_WAIT(); asm volatile("" ::: "memory");
        const int t = t0 + fr; const bool has_prev = (t % SEQ) != 0;
        const int bb = t0 / SEQ, cc = (t0 % SEQ) / 16;
        const int tp = t - (has_prev ? 1 : 0);
#pragma unroll 1
        for (int hd = 0; hd < 8; ++hd) {
        if (hd == 0) asm volatile("s_waitcnt vmcnt(0)\n\ts_barrier" ::: "memory"); else asm volatile("s_waitcnt vmcnt(8)\n\ts_barrier" ::: "memory");
        unsigned char* ops = a.ws + WS_OPS + (size_t)((bb * 8 + hd) * 256 + cc) * OPS_STRIDE;
        if (a.flags & 4) ops = (unsigned char*)a.out + (size_t)(blockIdx.x * 8 + wid) * OPS_STRIDE;
        u32x2 prc[4], pkc[4], pvc[4], prp[4], pkp[4], pvp[4];
#pragma unroll
        for (int i = 0; i < 4; ++i) { const int ch = 64 * hd + 16 * i + 4 * fq;
            prc[i] = *(const u32x2*)projr(PR, t, ch); pkc[i] = *(const u32x2*)projr(PR, t, 512 + ch); pvc[i] = *(const u32x2*)projr(PR, t, 1024 + ch);
            prp[i] = *(const u32x2*)projr(PR, tp, ch); pkp[i] = *(const u32x2*)projr(PR, tp, 512 + ch); pvp[i] = *(const u32x2*)projr(PR, tp, 1024 + ch);
            if (!has_prev) { prp[i] = (u32x2){0u, 0u}; pkp[i] = prp[i]; pvp[i] = prp[i]; } }
        f32x4 lw[4], la[4];
        {   bf16x8 bx[8];
#pragma unroll
            for (int ks = 0; ks < 8; ++ks) bx[ks] = *(const LAS bf16x8*)(Xs + fr * XP + ks * 32 + fq * 8);
#pragma unroll
            for (int i = 0; i < 4; ++i) {
                f32x4 cw = (f32x4){0.f, 0.f, 0.f, 0.f}, ca = cw, cg_ = cw;
#pragma unroll
                for (int ks = 0; ks < 2; ++ks) { const bf16x8 af = *(const LAS bf16x8*)(WB + (16 * i + fr) * 128 + (((ks * 4 + fq) ^ ((fr >> 1) & 7)) * 16)); cw = __builtin_amdgcn_mfma_f32_16x16x32_bf16(af, bx[ks], cw, 0, 0, 0); }
#pragma unroll
                for (int ks = 0; ks < 2; ++ks) { const bf16x8 af = *(const LAS bf16x8*)(WB + 8192 + (16 * i + fr) * 128 + (((ks * 4 + fq) ^ ((fr >> 1) & 7)) * 16)); ca = __builtin_amdgcn_mfma_f32_16x16x32_bf16(af, bx[2 + ks], ca, 0, 0, 0); }
#pragma unroll
                for (int ks = 0; ks < 4; ++ks) { const bf16x8 af = *(const LAS bf16x8*)(WB + 16384 + (16 * i + fr) * 256 + (((ks * 4 + fq) ^ fr) * 16)); cg_ = __builtin_amdgcn_mfma_f32_16x16x32_bf16(af, bx[4 + ks], cg_, 0, 0, 0); }
                lw[i] = cw; la[i] = ca;
                *(u32x2*)(ops + OP_G + i * 512 + fr * 32 + fq * 8) = (u32x2){pk2(cg_[0], cg_[1]), pk2(cg_[2], cg_[3])};
                asm volatile("" ::: "memory");
            }
        }
        float ssq = 0.f;
#pragma unroll
        for (int i = 0; i < 4; ++i) { const int ch = 64 * hd + 16 * i + 4 * fq;
            const f32x4 muk = *(const LAS f32x4*)(CT + 512 + ch), k_k = *(const LAS f32x4*)(CT + 2560 + ch);
#pragma unroll
            for (int e = 0; e < 4; ++e) { const float pk = (e & 1) ? bfhi(pkc[i][e >> 1]) : bflo(pkc[i][e >> 1]), pkv = (e & 1) ? bfhi(pkp[i][e >> 1]) : bflo(pkp[i][e >> 1]);
                const float kkr = (pk + (pkv - pk) * muk[e]) * k_k[e]; ssq += kkr * kkr; } }
        ssq += __shfl_xor(ssq, 16); ssq += __shfl_xor(ssq, 32);
        const float inv = 1.f / fmaxf(sqrtf(ssq), 1e-12f);
#pragma unroll
        for (int i = 0; i < 4; ++i) asm volatile("" :: "v"(prc[i]), "v"(pkc[i]), "v"(pvc[i]), "v"(prp[i]), "v"(pkp[i]), "v"(pvp[i]));
        asm volatile("s_waitcnt lgkmcnt(0)\n\ts_barrier" ::: "memory");
        if (hd < 7) P3_WDMA(hd + 1);
        f32x4 aab = (f32x4){0.f, 0.f, 0.f, 0.f}, aak = aab, arb = aab, ark = aab; float bon = 0.f;
#pragma unroll 1
        for (int s = 0; s < 2; ++s) {
            float r8[8], km8[8], kk8[8], b8[8], ld8[8];
#pragma unroll
            for (int ii = 0; ii < 2; ++ii) {
                const int i = 2 * s + ii;
                const f32x4 cw = lw[ii], ca = la[ii];
                const int chl = 16 * i + 4 * fq, ch = 64 * hd + chl;
                const f32x4 mur = *(const LAS f32x4*)(CT + ch), muk = *(const LAS f32x4*)(CT + 512 + ch), muv = *(const LAS f32x4*)(CT + 1024 + ch), w0 = *(const LAS f32x4*)(CT + 1536 + ch), a0 = *(const LAS f32x4*)(CT + 2048 + ch);
                const f32x4 k_k = *(const LAS f32x4*)(CT + 2560 + ch), k_a = *(const LAS f32x4*)(CT + 3072 + ch), r_k = *(const LAS f32x4*)(CT + 3584 + ch);
                float vv[4];
#pragma unroll
                for (int e = 0; e < 4; ++e) {
                    const float pr = (e & 1) ? bfhi(prc[ii][e >> 1]) : bflo(prc[ii][e >> 1]), prv = (e & 1) ? bfhi(prp[ii][e >> 1]) : bflo(prp[ii][e >> 1]);
                    const float pk = (e & 1) ? bfhi(pkc[ii][e >> 1]) : bflo(pkc[ii][e >> 1]), pkv = (e & 1) ? bfhi(pkp[ii][e >> 1]) : bflo(pkp[ii][e >> 1]);
                    const float pv = (e & 1) ? bfhi(pvc[ii][e >> 1]) : bflo(pvc[ii][e >> 1]), pvv = (e & 1) ? bfhi(pvp[ii][e >> 1]) : bflo(pvp[ii][e >> 1]);
                    const float r = pr + (prv - pr) * mur[e], k = pk + (pkv - pk) * muk[e]; vv[e] = pv + (pvv - pv) * muv[e];
                    const float z = w0[e] + cw[e];
                    const float sp = fmaxf(-z, 0.f) + __logf(1.f + __expf(-fabsf(z)));
                    const float wlog = -sp - 0.5f;
                    const float iclr = sigm_f(a0[e] + ca[e]);
                    const float kkn = k * k_k[e] * inv, km = k * (1.f + (iclr - 1.f) * k_a[e]);
                    r8[4 * ii + e] = r; km8[4 * ii + e] = km; kk8[4 * ii + e] = kkn; b8[4 * ii + e] = kkn * iclr; ld8[4 * ii + e] = -__expf(wlog);
                    bon += r * km * r_k[e];
                }
                *(u32x2*)(ops + OP_V + (chl >> 4) * 512 + fr * 32 + fq * 8) = (u32x2){pk2(vv[0], vv[1]), pk2(vv[2], vv[3])};
            }
            float rt[8], at[8], bt[8], kt[8], bh[8], kh[8], gcv[8];
#pragma unroll
            for (int j = 0; j < 8; ++j) {
                const float cum = prefix16(ld8[j]); const float tot = __shfl(cum, (lane & 48) | 15);
                const float e1 = __expf(cum), e2 = __expf(-cum), e3 = __expf(cum - ld8[j]), e4 = __expf(tot - cum);
                rt[j] = r8[j] * e1; at[j] = -kk8[j] * e3; bt[j] = b8[j] * e2; kt[j] = km8[j] * e2; bh[j] = b8[j] * e4; kh[j] = km8[j] * e4; gcv[j] = e1;
            }
            const bf16x8 RT = pack8(rt), AT = pack8(at), BT = pack8(bt), KT = pack8(kt);
            *(bf16x8*)(ops + OP_RP + ((s * 16 + fr) * 4 + fq) * 16) = RT;
#pragma unroll
            for (int ii = 0; ii < 2; ++ii) { const int chl = 16 * (2 * s + ii) + 4 * fq;
                *(LAS u32x2*)(AIMG + (fr * 64 + chl) * 2) = (u32x2){pk2(at[4 * ii], at[4 * ii + 1]), pk2(at[4 * ii + 2], at[4 * ii + 3])};
                *(u32x2*)(ops + OP_BH + (chl >> 4) * 512 + fr * 32 + fq * 8) = (u32x2){pk2(bh[4 * ii], bh[4 * ii + 1]), pk2(bh[4 * ii + 2], bh[4 * ii + 3])};
                *(u32x2*)(ops + OP_KH + (chl >> 4) * 512 + fr * 32 + fq * 8) = (u32x2){pk2(kh[4 * ii], kh[4 * ii + 1]), pk2(kh[4 * ii + 2], kh[4 * ii + 3])};
                if (fr == 15) *(f32x4*)(ops + OP_GC + chl * 4) = (f32x4){gcv[4 * ii], gcv[4 * ii + 1], gcv[4 * ii + 2], gcv[4 * ii + 3]}; }
            aab = __builtin_amdgcn_mfma_f32_16x16x32_bf16(AT, BT, aab, 0, 0, 0); aak = __builtin_amdgcn_mfma_f32_16x16x32_bf16(AT, KT, aak, 0, 0, 0);
            arb = __builtin_amdgcn_mfma_f32_16x16x32_bf16(RT, BT, arb, 0, 0, 0); ark = __builtin_amdgcn_mfma_f32_16x16x32_bf16(RT, KT, ark, 0, 0, 0);
#pragma unroll
            for (int ii = 0; ii < 2; ++ii) { lw[ii] = lw[2 + ii]; la[ii] = la[2 + ii]; prc[ii] = prc[2 + ii]; pkc[ii] = pkc[2 + ii]; pvc[ii] = pvc[2 + ii]; prp[ii] = prp[2 + ii]; pkp[ii] = pkp[2 + ii]; pvp[ii] = pvp[2 + ii]; }
        }
        bon += __shfl_xor(bon, 16); bon += __shfl_xor(bon, 32);
        if (fq == 0) *(float*)(ops + OP_BON + fr * 4) = bon;
#pragma unroll
        for (int e = 0; e < 4; ++e) { const int tq = 4 * fq + e; if (!(fr < tq)) { aab[e] = 0.f; aak[e] = 0.f; } if (!(fr <= tq)) { arb[e] = 0.f; ark[e] = 0.f; } }
        *(u32x2*)(ops + OP_ARBT + (fr * 16 + 4 * fq) * 2) = (u32x2){pk2(arb[0], arb[1]), pk2(arb[2], arb[3])};
        *(u32x2*)(ops + OP_ARKT + (fr * 16 + 4 * fq) * 2) = (u32x2){pk2(ark[0], ark[1]), pk2(ark[2], ark[3])};
        *(LAS f32x4*)(ATL + fr * 16 + 4 * fq) = aab;
        LDS_WAIT(); asm volatile("" ::: "memory");
        float x[16];
#pragma unroll
        for (int m = 0; m < 16; ++m) x[m] = (m == fr) ? 1.f : 0.f;
#pragma unroll
        for (int j = 14; j >= 0; --j) {
            float acc = x[j];
#pragma unroll
            for (int mq = (j + 1) / 4; mq < 4; ++mq) { const f32x4 col = *(const LAS f32x4*)(ATL + j * 16 + 4 * mq);
#pragma unroll
                for (int e = 0; e < 4; ++e) { const int m = 4 * mq + e; if (m > j) acc += x[m] * col[e]; } }
            x[j] = acc;
        }
        float xs[4];
#pragma unroll
        for (int e = 0; e < 4; ++e) xs[e] = (fq == 0) ? x[e] : (fq == 1) ? x[4 + e] : (fq == 2) ? x[8 + e] : x[12 + e];
        const bf16x8 xa = pack4z(xs[0], xs[1], xs[2], xs[3]);
        {   const f32x4 z4 = __builtin_amdgcn_mfma_f32_16x16x32_bf16(xa, pack4z(aak[0], aak[1], aak[2], aak[3]), (f32x4){0.f, 0.f, 0.f, 0.f}, 0, 0, 0);
            *(u32x2*)(ops + OP_ZT + (fr * 16 + 4 * fq) * 2) = (u32x2){pk2(z4[0], z4[1]), pk2(z4[2], z4[3])}; }
#pragma unroll
        for (int kt = 0; kt < 4; ++kt) {
            const s16x4 tr = vtr(AIMG + ((4 * fq + (fr >> 2)) * 64 + 16 * kt + 4 * (fr & 3)) * 2);
            const bf16x8 bw = (bf16x8){tr[0], tr[1], tr[2], tr[3], 0, 0, 0, 0};
            const f32x4 w4 = __builtin_amdgcn_mfma_f32_16x16x32_bf16(xa, bw, (f32x4){0.f, 0.f, 0.f, 0.f}, 0, 0, 0);
            *(u32x2*)(ops + OP_WT + ((16 * kt + fr) * 16 + 4 * fq) * 2) = (u32x2){pk2(w4[0], w4[1]), pk2(w4[2], w4[3])};
        }
        LDS_WAIT(); asm volatile("" ::: "memory");
        }
    }
}

constexpr int SC_NS = 9, SC_D = 7, SC_YB = SC_NS * OPS_STRIDE;
__device__ __forceinline__ void scan_unit(const Args& a, LAS unsigned char* lds, int bh) {
    const int tid = threadIdx.x, lane = tid & 63; const int wid = __builtin_amdgcn_readfirstlane(tid >> 6);
    const int b = bh >> 3, h = bh & 7;
    const unsigned char* ops_base = a.ws + WS_OPS + (size_t)bh * 256 * OPS_STRIDE;
    bf16_t* YIN = (bf16_t*)((unsigned char*)a.out + 64 * MiB);
    constexpr int NCH = SEQ / 16;
    asm volatile("s_waitcnt vmcnt(0) lgkmcnt(0)\n\ts_barrier" ::: "memory");
    if (wid == 4 || wid == 5) {
        const int pw = (wid - 4) * 7;
#define SC_ISSUE(c) do { const unsigned char* g_ = ops_base + (size_t)(c) * OPS_STRIDE + (pw * 1024) + lane * 16; const int so_ = ((c) % SC_NS) * OPS_STRIDE + pw * 1024; \
        _Pragma("unroll") for (int p_ = 0; p_ < 7; ++p_) __builtin_amdgcn_global_load_lds((const unsigned*)(g_ + p_ * 1024), (LAS unsigned*)(lds + so_ + p_ * 1024), 16, 0, 0); } while (0)
        for (int c = 0; c < SC_D; ++c) SC_ISSUE(c);
        for (int c = 0; c < NCH; ++c) {
            if (c <= NCH - SC_D) asm volatile("s_waitcnt vmcnt(35)\n\ts_barrier" ::: "memory"); else asm volatile("s_waitcnt vmcnt(0)\n\ts_barrier" ::: "memory");
            if (c + SC_D < NCH) SC_ISSUE(c + SC_D);
        }
        asm volatile("s_waitcnt vmcnt(0)\n\ts_barrier" ::: "memory");
        asm volatile("s_barrier" ::: "memory");
#undef SC_ISSUE
    } else if (wid < 4) {
        const int vl = lane & 15, g = lane >> 4, i4 = (lane & 15) >> 2, p4 = lane & 3;
        f32x4 st[4];
#pragma unroll
        for (int kt = 0; kt < 4; ++kt) st[kt] = (f32x4){0.f, 0.f, 0.f, 0.f};
        const int trw = ((4 * g + i4) * 16 + 4 * p4) * 2;
        const int trk = ((4 * g + i4) * 64 + 4 * p4) * 2;
#define SC_FDECL(X) bf16x8 X##wa0, X##wa1, X##rp0, X##rp1; s16x4 X##zt, X##vt, X##ab, X##ak, X##bh0, X##bh1, X##bh2, X##bh3, X##kh0, X##kh1, X##kh2, X##kh3; f32x4 X##gc0, X##gc1, X##gc2, X##gc3
#define SC_FLOAD(X, c_) do { const LAS unsigned char* sl_ = lds + ((c_) % SC_NS) * OPS_STRIDE; \
        { const s16x4 a_ = vtr(sl_ + OP_WT + trw), b_ = vtr(sl_ + OP_WT + 16 * 32 + trw); X##wa0 = (bf16x8){a_[0], a_[1], a_[2], a_[3], b_[0], b_[1], b_[2], b_[3]}; } \
        { const s16x4 a_ = vtr(sl_ + OP_WT + 32 * 32 + trw), b_ = vtr(sl_ + OP_WT + 48 * 32 + trw); X##wa1 = (bf16x8){a_[0], a_[1], a_[2], a_[3], b_[0], b_[1], b_[2], b_[3]}; } \
        X##rp0 = *(const LAS bf16x8*)(sl_ + OP_RP + ((0 * 16 + vl) * 4 + g) * 16); X##rp1 = *(const LAS bf16x8*)(sl_ + OP_RP + ((1 * 16 + vl) * 4 + g) * 16); \
        X##zt = vtr(sl_ + OP_ZT + trw); X##vt = vtr(sl_ + OP_V + trw + 512 * wid); X##ab = vtr(sl_ + OP_ARBT + trw); X##ak = vtr(sl_ + OP_ARKT + trw); \
        X##bh0 = vtr(sl_ + OP_BH + trw); X##bh1 = vtr(sl_ + OP_BH + trw + 512); X##bh2 = vtr(sl_ + OP_BH + trw + 1024); X##bh3 = vtr(sl_ + OP_BH + trw + 1536); \
        X##kh0 = vtr(sl_ + OP_KH + trw); X##kh1 = vtr(sl_ + OP_KH + trw + 512); X##kh2 = vtr(sl_ + OP_KH + trw + 1024); X##kh3 = vtr(sl_ + OP_KH + trw + 1536); \
        X##gc0 = *(const LAS f32x4*)(sl_ + OP_GC + (4 * g) * 4); X##gc1 = *(const LAS f32x4*)(sl_ + OP_GC + (16 + 4 * g) * 4); X##gc2 = *(const LAS f32x4*)(sl_ + OP_GC + (32 + 4 * g) * 4); X##gc3 = *(const LAS f32x4*)(sl_ + OP_GC + (48 + 4 * g) * 4); } while (0)
#define SC_STEP(X, c_) do { bf16x8 sb0_, sb1_; \
        { u32x4 w_ = (u32x4){pk2(st[0][0], st[0][1]), pk2(st[0][2], st[0][3]), pk2(st[1][0], st[1][1]), pk2(st[1][2], st[1][3])}; sb0_ = __builtin_bit_cast(bf16x8, w_); } \
        { u32x4 w_ = (u32x4){pk2(st[2][0], st[2][1]), pk2(st[2][2], st[2][3]), pk2(st[3][0], st[3][1]), pk2(st[3][2], st[3][3])}; sb1_ = __builtin_bit_cast(bf16x8, w_); } \
        f32x4 u_ = (f32x4){0.f, 0.f, 0.f, 0.f}, y_ = u_; \
        u_ = __builtin_amdgcn_mfma_f32_16x16x32_bf16(X##wa0, sb0_, u_, 0, 0, 0); u_ = __builtin_amdgcn_mfma_f32_16x16x32_bf16(X##wa1, sb1_, u_, 0, 0, 0); \
        u_ = __builtin_amdgcn_mfma_f32_16x16x32_bf16((bf16x8){X##zt[0], X##zt[1], X##zt[2], X##zt[3], 0, 0, 0, 0}, (bf16x8){X##vt[0], X##vt[1], X##vt[2], X##vt[3], 0, 0, 0, 0}, u_, 0, 0, 0); \
        y_ = __builtin_amdgcn_mfma_f32_16x16x32_bf16(X##rp0, sb0_, y_, 0, 0, 0); y_ = __builtin_amdgcn_mfma_f32_16x16x32_bf16(X##rp1, sb1_, y_, 0, 0, 0); \
        bf16x8 uv_; { u32x2 uw_ = (u32x2){pk2(u_[0], u_[1]), pk2(u_[2], u_[3])}; const s16x4 us_ = __builtin_bit_cast(s16x4, uw_); uv_ = (bf16x8){us_[0], us_[1], us_[2], us_[3], X##vt[0], X##vt[1], X##vt[2], X##vt[3]}; } \
        st[0] = __builtin_amdgcn_mfma_f32_16x16x32_bf16((bf16x8){X##bh0[0], X##bh0[1], X##bh0[2], X##bh0[3], X##kh0[0], X##kh0[1], X##kh0[2], X##kh0[3]}, uv_, st[0] * X##gc0, 0, 0, 0); \
        st[1] = __builtin_amdgcn_mfma_f32_16x16x32_bf16((bf16x8){X##bh1[0], X##bh1[1], X##bh1[2], X##bh1[3], X##kh1[0], X##kh1[1], X##kh1[2], X##kh1[3]}, uv_, st[1] * X##gc1, 0, 0, 0); \
        st[2] = __builtin_amdgcn_mfma_f32_16x16x32_bf16((bf16x8){X##bh2[0], X##bh2[1], X##bh2[2], X##bh2[3], X##kh2[0], X##kh2[1], X##kh2[2], X##kh2[3]}, uv_, st[2] * X##gc2, 0, 0, 0); \
        st[3] = __builtin_amdgcn_mfma_f32_16x16x32_bf16((bf16x8){X##bh3[0], X##bh3[1], X##bh3[2], X##bh3[3], X##kh3[0], X##kh3[1], X##kh3[2], X##kh3[3]}, uv_, st[3] * X##gc3, 0, 0, 0); \
        y_ = __builtin_amdgcn_mfma_f32_16x16x32_bf16((bf16x8){X##ab[0], X##ab[1], X##ab[2], X##ab[3], X##ak[0], X##ak[1], X##ak[2], X##ak[3]}, uv_, y_, 0, 0, 0); \
        LAS float* yb_ = (LAS float*)(lds + SC_YB + ((c_) & 1) * 4096) + 16 * wid + vl; \
        _Pragma("unroll") for (int e = 0; e < 4; ++e) yb_[(4 * g + e) * 64] = y_[e]; } while (0)
        SC_FDECL(fa_); SC_FDECL(fb_);
        for (int c = 0; c < NCH; c += 2) {
            asm volatile("s_waitcnt lgkmcnt(0)\n\ts_barrier" ::: "memory");
            if (c == 0) SC_FLOAD(fa_, 0);
            SC_FLOAD(fb_, c + 1);
            SC_STEP(fa_, c);
            asm volatile("s_waitcnt lgkmcnt(0)\n\ts_barrier" ::: "memory");
            if (c + 2 < NCH) SC_FLOAD(fa_, c + 2);
            SC_STEP(fb_, c + 1);
        }
#undef SC_FDECL
#undef SC_FLOAD
#undef SC_STEP
        asm volatile("s_waitcnt lgkmcnt(0)\n\ts_barrier" ::: "memory");
        asm volatile("s_barrier" ::: "memory");
    } else {
        const int pi = tid - 384, ptk = pi >> 3, pc8 = (pi & 7) * 8;
        const f32x4 lg0 = *(const f32x4*)(a.in[I_LNXG] + h * 64 + pc8), lg1 = *(const f32x4*)(a.in[I_LNXG] + h * 64 + pc8 + 4), lb0 = *(const f32x4*)(a.in[I_LNXB] + h * 64 + pc8), lb1 = *(const f32x4*)(a.in[I_LNXB] + h * 64 + pc8 + 4);
#define SC_POST(cc) do { const LAS unsigned char* sl_ = lds + ((cc) % SC_NS) * OPS_STRIDE; const LAS float* yb_ = (const LAS float*)(lds + SC_YB + ((cc) & 1) * 4096) + ptk * 64 + pc8; \
        const f32x4 y0_ = *(const LAS f32x4*)yb_, y1_ = *(const LAS f32x4*)(yb_ + 4); \
        const float mean_ = sum8(((y0_[0] + y0_[1]) + (y0_[2] + y0_[3])) + ((y1_[0] + y1_[1]) + (y1_[2] + y1_[3]))) * (1.f / 64.f); \
        const f32x4 d0_ = y0_ - mean_, d1_ = y1_ - mean_; \
        const float var_ = sum8(((d0_[0] * d0_[0] + d0_[1] * d0_[1]) + (d0_[2] * d0_[2] + d0_[3] * d0_[3])) + ((d1_[0] * d1_[0] + d1_[1] * d1_[1]) + (d1_[2] * d1_[2] + d1_[3] * d1_[3]))) * (1.f / 64.f); \
        const float rstd_ = 1.0f / sqrtf(var_ + LNX_EPS); \
        const u32x4 vw_ = *(const LAS u32x4*)(sl_ + OP_V + (pc8 >> 4) * 512 + ptk * 32 + (pc8 & 15) * 2), gw_ = *(const LAS u32x4*)(sl_ + OP_G + (pc8 >> 4) * 512 + ptk * 32 + (pc8 & 15) * 2); \
        const float bon_ = *(const LAS float*)(sl_ + OP_BON + ptk * 4); \
        const f32x4 v0_ = (f32x4){bflo(vw_[0]), bfhi(vw_[0]), bflo(vw_[1]), bfhi(vw_[1])}, v1_ = (f32x4){bflo(vw_[2]), bfhi(vw_[2]), bflo(vw_[3]), bfhi(vw_[3])}; \
        const f32x4 g0_ = (f32x4){bflo(gw_[0]), bfhi(gw_[0]), bflo(gw_[1]), bfhi(gw_[1])}, g1_ = (f32x4){bflo(gw_[2]), bfhi(gw_[2]), bflo(gw_[3]), bfhi(gw_[3])}; \
        const f32x4 o0_ = (d0_ * rstd_ * lg0 + lb0 + bon_ * v0_) * g0_, o1_ = (d1_ * rstd_ * lg1 + lb1 + bon_ * v1_) * g1_; \
        const size_t t_ = (size_t)b * SEQ + (size_t)(cc) * 16 + ptk; \
        *(u32x4*)(YIN + t_ * 1024 + 512 + h * 64 + pc8) = (u32x4){pk2(o0_[0], o0_[1]), pk2(o0_[2], o0_[3]), pk2(o1_[0], o1_[1]), pk2(o1_[2], o1_[3])}; } while (0)
        for (int c = 0; c < NCH; ++c) {
            asm volatile("s_waitcnt lgkmcnt(0)\n\ts_barrier" ::: "memory");
            if (c > 0) SC_POST(c - 1);
        }
        asm volatile("s_waitcnt lgkmcnt(0)\n\ts_barrier" ::: "memory");
        SC_POST(NCH - 1);
        asm volatile("s_waitcnt lgkmcnt(0)\n\ts_barrier" ::: "memory");
#undef SC_POST
    }
}

constexpr int AT_SLOT = 32768;
constexpr int AT_WSF = 4 * AT_SLOT;
constexpr int AT_XP = 132;
constexpr float AT_THR = 8.f;
#define MFMA16(A, B, C) __builtin_amdgcn_mfma_f32_16x16x32_bf16(A, B, C, 0, 0, 0)
__device__ __forceinline__ float max_over_rows(float m) {
    { auto r = __builtin_amdgcn_permlane16_swap(__float_as_uint(m), __float_as_uint(m), false, false); m = fmaxf(__uint_as_float(r[0]), __uint_as_float(r[1])); }
    { auto r = __builtin_amdgcn_permlane32_swap(__float_as_uint(m), __float_as_uint(m), false, false); m = fmaxf(__uint_as_float(r[0]), __uint_as_float(r[1])); }
    return m;
}
__device__ __forceinline__ void attn_unit(const Args& a, LAS unsigned char* lds, int b, int h, int u, float lam) {
    const int tid = threadIdx.x, lane = tid & 63, c16 = lane & 15, g = lane >> 4; const int wid = __builtin_amdgcn_readfirstlane(tid >> 6);
    const int comp = wid >> 2, wq = wid & 3;
    const bf16_t* PROJ = (const bf16_t*)(a.ws + WS_PROJ);
    bf16_t* YIN = (bf16_t*)((unsigned char*)a.out + 64 * MiB);
    const size_t rowbase = (size_t)b * SEQ; const int q0 = u * 128;
    const int NT = 2 * u + 2;
    const int ntw = (q0 + 32 * wq) / 64 + 1;
    LAS float* wsf = (LAS float*)(lds + AT_WSF) + wid * 64;
    const bf16_t* kvsrc0 = PROJ + (size_t)TOK * 512 + (size_t)(b * 4 + h) * 64 * 16384 + wid * 512 + lane * 8;
#define AT_DMA(t) do { const bf16_t* s_ = kvsrc0 + (size_t)(t) * 16384; LAS unsigned char* S_ = lds + ((t) & 3) * AT_SLOT + wid * 1024; \
        __builtin_amdgcn_global_load_lds((const unsigned*)(s_), (LAS unsigned*)(S_), 16, 0, 0); \
        __builtin_amdgcn_global_load_lds((const unsigned*)(s_ + 4096), (LAS unsigned*)(S_ + 8192), 16, 0, 0); \
        __builtin_amdgcn_global_load_lds((const unsigned*)(s_ + 8192), (LAS unsigned*)(S_ + 16384), 16, 0, 0); \
        __builtin_amdgcn_global_load_lds((const unsigned*)(s_ + 12288), (LAS unsigned*)(S_ + 16384 + 8192), 16, 0, 0); } while (0)
    asm volatile("s_waitcnt vmcnt(0) lgkmcnt(0)\n\ts_barrier" ::: "memory");
    const bf16_t* Qw = PROJ + (rowbase + q0 + 32 * wq + c16) * 512 + h * 128 + comp * 64 + 8 * g;
    bf16x8 qf[2][2];
#pragma unroll
    for (int rb = 0; rb < 2; ++rb)
#pragma unroll
        for (int s = 0; s < 2; ++s) qf[rb][s] = *(const bf16x8*)(Qw + (size_t)(16 * rb) * 512 + 32 * s);
    asm volatile("s_waitcnt vmcnt(0)" : "+v"(qf[0][0]), "+v"(qf[0][1]), "+v"(qf[1][0]), "+v"(qf[1][1]) :: "memory");
    AT_DMA(0);
    if (NT > 1) AT_DMA(1);
    if (NT > 2) AT_DMA(2);
    f32x4 o[2][8], lacc[2];
#pragma unroll
    for (int rb = 0; rb < 2; ++rb) { lacc[rb] = (f32x4){0.f, 0.f, 0.f, 0.f};
#pragma unroll
        for (int n = 0; n < 8; ++n) o[rb][n] = (f32x4){0.f, 0.f, 0.f, 0.f}; }
    float mhat[2] = {0.f, 0.f};
    const int qi0 = q0 + 32 * wq + c16;
    const int koff = comp * 8192 + g * 1024 + c16 * 16;
    const int voff = 16384 + (4 * g + (c16 >> 2)) * 64 + (c16 & 3) * 8;
    const bf16x8 ones = (bf16x8){0x3F80, 0x3F80, 0x3F80, 0x3F80, 0x3F80, 0x3F80, 0x3F80, 0x3F80};
    if (NT > 2) asm volatile("s_waitcnt vmcnt(8)\n\ts_barrier" ::: "memory"); else if (NT > 1) asm volatile("s_waitcnt vmcnt(4)\n\ts_barrier" ::: "memory"); else asm volatile("s_waitcnt vmcnt(0)\n\ts_barrier" ::: "memory");
    for (int t = 0; t < NT; ++t) {
        if (t + 3 < NT) AT_DMA(t + 3);
        if (t < ntw) {
            const LAS unsigned char* Kb = lds + (t & 3) * AT_SLOT + koff;
            const LAS unsigned char* Vb = lds + (t & 3) * AT_SLOT + voff;
            f32x4 st[2][4];
#pragma unroll
            for (int rb = 0; rb < 2; ++rb)
#pragma unroll
                for (int kt = 0; kt < 4; ++kt) st[rb][kt] = (f32x4){-mhat[rb], -mhat[rb], -mhat[rb], -mhat[rb]};
#pragma unroll
            for (int s = 0; s < 2; ++s)
#pragma unroll
                for (int kt = 0; kt < 4; ++kt) { const bf16x8 kf = *(const LAS bf16x8*)(Kb + s * 4096 + kt * 256);
                    st[0][kt] = MFMA16(kf, qf[0][s], st[0][kt]); st[1][kt] = MFMA16(kf, qf[1][s], st[1][kt]); }
            const int kv0 = t * 64;
            if (kv0 + 63 > q0 + 32 * wq) {
#pragma unroll
                for (int kt = 0; kt < 4; ++kt)
#pragma unroll
                    for (int e = 0; e < 4; ++e) { const int kv = kv0 + 16 * kt + 4 * g + e; if (kv > qi0) st[0][kt][e] = -INFINITY; if (kv > qi0 + 16) st[1][kt][e] = -INFINITY; }
            }
            float rm[2];
#pragma unroll
            for (int rb = 0; rb < 2; ++rb) { float m = fmaxf(fmaxf(st[rb][0][0], st[rb][0][1]), fmaxf(st[rb][0][2], st[rb][0][3]));
#pragma unroll
                for (int kt = 1; kt < 4; ++kt) m = fmaxf(fmaxf(m, st[rb][kt][0]), fmaxf(fmaxf(st[rb][kt][1], st[rb][kt][2]), st[rb][kt][3]));
                rm[rb] = max_over_rows(m); }
            if (t == 0 || __any(fmaxf(rm[0], rm[1]) > AT_THR)) {
#pragma unroll
                for (int rb = 0; rb < 2; ++rb) {
                    const float dl = (t == 0) ? rm[rb] : fmaxf(rm[rb], 0.f);
                    mhat[rb] += dl;
#pragma unroll
                    for (int kt = 0; kt < 4; ++kt) st[rb][kt] = st[rb][kt] - dl;
                    if (g == 0) wsf[16 * rb + c16] = __builtin_amdgcn_exp2f(-dl);
                }
                if (t != 0) {
                    LDS_WAIT();
#pragma unroll
                    for (int rb = 0; rb < 2; ++rb) { const f32x4 f4 = *(const LAS f32x4*)(wsf + 16 * rb + 4 * g);
                        lacc[rb] = lacc[rb] * f4;
#pragma unroll
                        for (int n = 0; n < 8; ++n) o[rb][n] = o[rb][n] * f4; }
                }
                LDS_WAIT();
            }
            bf16x8 pa[2][2];
#pragma unroll
            for (int rb = 0; rb < 2; ++rb) {
#pragma unroll
                for (int kt = 0; kt < 4; ++kt)
#pragma unroll
                    for (int e = 0; e < 4; ++e) st[rb][kt][e] = __builtin_amdgcn_exp2f(st[rb][kt][e]);
#pragma unroll
                for (int sp = 0; sp < 2; ++sp) { const f32x4 x0 = st[rb][2 * sp], x1 = st[rb][2 * sp + 1];
                    u32x4 w = (u32x4){pk2(x0[0], x0[1]), pk2(x0[2], x0[3]), pk2(x1[0], x1[1]), pk2(x1[2], x1[3])}; pa[rb][sp] = __builtin_bit_cast(bf16x8, w); }
            }
#pragma unroll
            for (int rb = 0; rb < 2; ++rb)
#pragma unroll
                for (int sp = 0; sp < 2; ++sp) lacc[rb] = MFMA16(pa[rb][sp], ones, lacc[rb]);
#pragma unroll
            for (int n = 0; n < 8; ++n)
#pragma unroll
                for (int sp = 0; sp < 2; ++sp) {
                    const LAS unsigned char* vp = Vb + (n >> 1) * 4096 + (n & 1) * 32 + sp * 2048;
                    const s16x4 lo = vtr(vp), hv = vtr(vp + 1024);
                    const bf16x8 vf = (bf16x8){lo[0], lo[1], lo[2], lo[3], hv[0], hv[1], hv[2], hv[3]};
                    o[0][n] = MFMA16(pa[0][sp], vf, o[0][n]); o[1][n] = MFMA16(pa[1][sp], vf, o[1][n]);
                }
        }
        if (t + 3 < NT) asm volatile("s_waitcnt vmcnt(8) lgkmcnt(0)\n\ts_barrier" ::: "memory");
        else if (t + 2 < NT) asm volatile("s_waitcnt vmcnt(4) lgkmcnt(0)\n\ts_barrier" ::: "memory");
        else asm volatile("s_waitcnt vmcnt(0) lgkmcnt(0)\n\ts_barrier" ::: "memory");
    }
    LAS float* Xt = (LAS float*)lds + wq * (32 * AT_XP);
    if (comp == 1) {
#pragma unroll
        for (int rb = 0; rb < 2; ++rb)
#pragma unroll
            for (int e = 0; e < 4; ++e) { const float rl = 1.0f / lacc[rb][e];
#pragma unroll
                for (int n = 0; n < 8; ++n) Xt[(16 * rb + 4 * g + e) * AT_XP + 16 * n + c16] = o[rb][n][e] * rl; }
    }
    __syncthreads();
    if (comp == 0) {
#pragma unroll
        for (int rb = 0; rb < 2; ++rb)
#pragma unroll
            for (int e = 0; e < 4; ++e) { const float rl = 1.0f / lacc[rb][e];
#pragma unroll
                for (int n = 0; n < 8; ++n) { LAS float* p = Xt + (16 * rb + 4 * g + e) * AT_XP + 16 * n + c16; *p = o[rb][n][e] * rl - lam * (*p); } }
        LDS_WAIT(); asm volatile("" ::: "memory");
        const int row = lane >> 1, half = lane & 1;
        const LAS float* rp = Xt + row * AT_XP + half * 64;
        f32x4 v[16]; float ss = 0.f;
#pragma unroll
        for (int i = 0; i < 16; ++i) { v[i] = *(const LAS f32x4*)(rp + 4 * i); ss += (v[i][0] * v[i][0] + v[i][1] * v[i][1]) + (v[i][2] * v[i][2] + v[i][3] * v[i][3]); }
        ss += __shfl_xor(ss, 1);
        const float rstd = 0.8f / sqrtf(ss * (1.f / 128.f) + SUBLN_EPS);
        const float* sg = a.in[I_SUBLN] + half * 64;
        bf16_t* op = YIN + (rowbase + q0 + 32 * wq + row) * 1024 + h * 128 + half * 64;
#pragma unroll
        for (int i = 0; i < 8; ++i) { const f32x4 g0 = *(const f32x4*)(sg + 8 * i), g1 = *(const f32x4*)(sg + 8 * i + 4); const f32x4 x0 = v[2 * i] * rstd * g0, x1 = v[2 * i + 1] * rstd * g1;
            *(u32x4*)(op + 8 * i) = (u32x4){pk2(x0[0], x0[1]), pk2(x0[2], x0[3]), pk2(x1[0], x1[1]), pk2(x1[2], x1[3])}; }
    }
    __syncthreads();
#undef AT_DMA
}
#undef MFMA16

__device__ __forceinline__ void phase4(const Args& a, LAS unsigned char* lds) {
    const int tid = threadIdx.x;
    if (!(a.flags & 1)) for (int bh = blockIdx.x; bh < 64; bh += gridDim.x) scan_unit(a, lds, bh);
    if (a.flags & 2) return;
    float lam;
    { const int l = tid & 63; const float s1 = wave_sum(a.in[I_LQ1][l] * a.in[I_LK1][l]), s2 = wave_sum(a.in[I_LQ2][l] * a.in[I_LK2][l]); lam = __expf(s1) - __expf(s2) + 0.2f; }
    unsigned* ctl = (unsigned*)(a.ws + WS_CTL);
    LAS unsigned* qslot = (LAS unsigned*)(lds + 147456 - 64);
    for (;;) {
        __syncthreads();
        if (tid == 0) *qslot = atomicAdd(ctl + CW_QUEUE, 1u);
        __syncthreads();
        const unsigned idx = *qslot;
        if (idx >= 1024u) break;
        const int u = 31 - (int)(idx >> 5), bh = (int)(idx & 31);
        attn_unit(a, lds, bh >> 2, bh & 3, u, lam);
    }
}

__device__ __forceinline__ void phase6(const Args& a, LAS unsigned char* lds) {
    const int tid = threadIdx.x, lane = tid & 63, wid = __builtin_amdgcn_readfirstlane(tid >> 6);
    LAS float* cG = (LAS float*)lds; LAS float* cA = cG + 1024; LAS float* cB = cA + 1024;
    const bf16_t* YM = (const bf16_t*)(a.ws + WS_YMIX); const float* SSQ = (const float*)(a.ws + WS_SSQ1);
    bf16_t* H2 = (bf16_t*)(a.ws + WS_H2);
    for (int rb = blockIdx.x; rb < TOK / 128; rb += gridDim.x) {
        const int b = rb / 32;
        __syncthreads();
        for (int j = tid; j < 1024; j += NTHREADS) { cG[j] = ada_val(a, b, 2048 + j) * a.in[I_GPOSTMIX][j]; cA[j] = a.in[I_GPREFFN][j] * (1.f + ada_val(a, b, 4096 + j)); cB[j] = ada_val(a, b, 3072 + j); }
        __syncthreads();
        for (int rr = wid; rr < 128; rr += 2 * NWAVES) {
            const size_t row0 = (size_t)rb * 128 + rr;
            f32x4 xv[2][4]; u32x2 yv[2][4]; float sq[2];
#pragma unroll
            for (int q = 0; q < 2; ++q) { const size_t row = row0 + q * NWAVES; sq[q] = (lane < 16) ? SSQ[row * 16 + lane] : 0.f;
                const f32x4* xr = (const f32x4*)(a.in[I_X] + row * DM) + lane; const u32x2* yr = (const u32x2*)(YM + row * DM) + lane;
#pragma unroll
                for (int j = 0; j < 4; ++j) { xv[q][j] = __builtin_nontemporal_load(xr + 64 * j); yv[q][j] = __builtin_nontemporal_load(yr + 64 * j); } }
#pragma unroll
            for (int q = 0; q < 2; ++q) { const size_t row = row0 + q * NWAVES;
                const float rstd0 = 1.0f / sqrtf(wave_sum(sq[q]) * (1.f / DM) + RMS_EPS);
                f32x4 v[4]; float s = 0.f;
#pragma unroll
                for (int j = 0; j < 4; ++j) { const u32x2 yw = yv[q][j]; const f32x4 y = (f32x4){bflo(yw[0]), bfhi(yw[0]), bflo(yw[1]), bfhi(yw[1])};
                    const f32x4 g = *(const LAS f32x4*)(cG + 4 * lane + 256 * j);
                    v[j] = xv[q][j] + g * y * rstd0; s += (v[j].x * v[j].x + v[j].y * v[j].y) + (v[j].z * v[j].z + v[j].w * v[j].w); }
                const float rstd = 1.0f / sqrtf(wave_sum(s) * (1.f / DM) + RMS_EPS);
                unsigned long long* o8 = (unsigned long long*)(H2 + row * DM) + lane;
#pragma unroll
                for (int j = 0; j < 4; ++j) {
                    const f32x4 ca = *(const LAS f32x4*)(cA + 4 * lane + 256 * j), cb = *(const LAS f32x4*)(cB + 4 * lane + 256 * j);
                    const f32x4 hh = v[j] * rstd * ca + cb;
                    o8[64 * j] = (unsigned long long)pk2(hh.x, hh.y) | ((unsigned long long)pk2(hh.z, hh.w) << 32); }
            }
        }
    }
}
__device__ __forceinline__ void phase9(const Args& a, LAS unsigned char* lds) {
    const int tid = threadIdx.x, lane = tid & 63, wid = __builtin_amdgcn_readfirstlane(tid >> 6);
    LAS float* cG = (LAS float*)lds; LAS float* cM = cG + 1024;
    const bf16_t* FF = (const bf16_t*)(a.ws + WS_F); const float* SSQ = (const float*)(a.ws + WS_SSQ2);
    const bf16_t* YM = (const bf16_t*)(a.ws + WS_YMIX); const float* SSQ1 = (const float*)(a.ws + WS_SSQ1);
    for (int rb = blockIdx.x; rb < TOK / 128; rb += gridDim.x) {
        const int b = rb / 32;
        __syncthreads();
        for (int j = tid; j < 1024; j += NTHREADS) { cG[j] = ada_val(a, b, 5120 + j) * a.in[I_GPOSTFFN][j]; cM[j] = ada_val(a, b, 2048 + j) * a.in[I_GPOSTMIX][j]; }
        __syncthreads();
        for (int rr = wid; rr < 128; rr += 2 * NWAVES) {
            const size_t row0 = (size_t)rb * 128 + rr;
            f32x4 xv[2][4]; u32x2 yv[2][4], mv[2][4]; float sq[2], sm[2];
#pragma unroll
            for (int q = 0; q < 2; ++q) { const size_t row = row0 + q * NWAVES; sq[q] = (lane < 16) ? SSQ[row * 16 + lane] : 0.f; sm[q] = (lane < 16) ? SSQ1[row * 16 + lane] : 0.f;
                const f32x4* xr = (const f32x4*)(a.in[I_X] + row * DM) + lane; const u32x2* yr = (const u32x2*)(FF + row * DM) + lane; const u32x2* mr = (const u32x2*)(YM + row * DM) + lane;
#pragma unroll
                for (int j = 0; j < 4; ++j) { xv[q][j] = __builtin_nontemporal_load(xr + 64 * j); yv[q][j] = __builtin_nontemporal_load(yr + 64 * j); mv[q][j] = __builtin_nontemporal_load(mr + 64 * j); } }
#pragma unroll
            for (int q = 0; q < 2; ++q) { const size_t row = row0 + q * NWAVES;
                const float rstd0 = 1.0f / sqrtf(wave_sum(sq[q]) * (1.f / DM) + RMS_EPS), rstdm = 1.0f / sqrtf(wave_sum(sm[q]) * (1.f / DM) + RMS_EPS);
                f32x4* orow = (f32x4*)(a.out + row * DM) + lane;
#pragma unroll
                for (int j = 0; j < 4; ++j) { const u32x2 yw = yv[q][j], mw = mv[q][j];
                    const f32x4 y = (f32x4){bflo(yw[0]), bfhi(yw[0]), bflo(yw[1]), bfhi(yw[1])}, m = (f32x4){bflo(mw[0]), bfhi(mw[0]), bflo(mw[1]), bfhi(mw[1])};
                    const f32x4 g = *(const LAS f32x4*)(cG + 4 * lane + 256 * j), gm = *(const LAS f32x4*)(cM + 4 * lane + 256 * j);
                    const f32x4 x1 = xv[q][j] + gm * m * rstdm;
                    __builtin_nontemporal_store(x1 + g * y * rstd0, orow + 64 * j); }
            }
        }
    }
}

#define XB_TMO      128
#define XB_XCNT(j)  (256  + 64 * (j))
#define XB_XSUB(j)  (1280 + 64 * (j))
#define XB_XGEN(j)  (2304 + 64 * (j))
#define XB_TOP      3328
#define XB_TOPGEN   3392
#define XCD_BAR_WORDS 3456
#define XB_SPIN_CAP (1u << 18)
__device__ __forceinline__ unsigned xb_ld(unsigned* p)              { return __hip_atomic_load(p, __ATOMIC_RELAXED, __HIP_MEMORY_SCOPE_AGENT); }
__device__ __forceinline__ unsigned xb_add(unsigned* p, unsigned v) { return __hip_atomic_fetch_add(p, v, __ATOMIC_RELAXED, __HIP_MEMORY_SCOPE_AGENT); }
__device__ __forceinline__ unsigned xb_xcc_id() { return (unsigned)__builtin_amdgcn_s_getreg((3 << 11) | 20) & 0xFu; }
#define XB_SPIN(cond, bar) do { unsigned _sp = 0; while (cond) { __builtin_amdgcn_s_sleep(1); \
    if ((++_sp & 255u) == 0u) { if (xb_ld(&(bar)[XB_TMO])) break; if (_sp > XB_SPIN_CAP) { atomicAdd(&(bar)[XB_TMO], 1u); break; } } } } while (0)
struct XcdBarrier { unsigned* bar; unsigned x; volatile LAS unsigned* st; };
__device__ __forceinline__ XcdBarrier xcd_barrier_post(unsigned* bar, volatile LAS unsigned* st) {
    XcdBarrier b; b.bar = bar; b.x = xb_xcc_id(); b.st = st;
    if (threadIdx.x == 0) (void)xb_add(&bar[XB_XCNT(b.x)], 1u);
    return b;
}
__device__ __forceinline__ void xcd_barrier_complete(unsigned* bar, unsigned x, unsigned& nloc, unsigned& nx) {
    const unsigned G = gridDim.x * gridDim.y * gridDim.z;
    unsigned sum, cnt, mine, sp = 0u;
    for (;;) {
        sum = 0u; cnt = 0u; mine = 0u;
#pragma unroll
        for (unsigned j = 0; j < 16; ++j) { const unsigned c = xb_ld(&bar[XB_XCNT(j)]); sum += c; cnt += (c > 0u) ? 1u : 0u; mine = (j == x) ? c : mine; }
        if (sum == G) break;
        __builtin_amdgcn_s_sleep(1);
        if ((++sp & 255u) == 0u) { if (xb_ld(&bar[XB_TMO])) break; if (sp > XB_SPIN_CAP) { atomicAdd(&bar[XB_TMO], 1u); break; } }
    }
    nloc = mine > 0u ? mine : 1u; nx = cnt > 0u ? cnt : 1u;
}
__device__ __forceinline__ void xcd_barrier(const XcdBarrier& b) {
    asm volatile("s_waitcnt vmcnt(0)" ::: "memory");
    __syncthreads();
    if (threadIdx.x == 0) {
        unsigned* bar = b.bar;
        __builtin_amdgcn_s_waitcnt(0);
        unsigned nloc = b.st[0], nx = b.st[1];
        if (nloc == 0u) { xcd_barrier_complete(bar, b.x, nloc, nx); b.st[0] = nloc; b.st[1] = nx; }
        const unsigned old = xb_add(&bar[XB_XSUB(b.x)], 1u);
        const unsigned gen = old / nloc;
        if (old + 1u == (gen + 1u) * nloc) {
            __builtin_amdgcn_fence(__ATOMIC_RELEASE, "agent");
            asm volatile("s_waitcnt vmcnt(0)" ::: "memory");
            const unsigned og = xb_add(&bar[XB_TOP], 1u);
            const unsigned tg = og / nx;
            if (og + 1u == (tg + 1u) * nx) xb_add(&bar[XB_TOPGEN], 1u);
            else XB_SPIN(xb_ld(&bar[XB_TOPGEN]) == tg, bar);
            __builtin_amdgcn_fence(__ATOMIC_ACQUIRE, "agent");
            xb_add(&bar[XB_XGEN(b.x)], 1u);
            asm volatile("s_waitcnt vmcnt(0)" ::: "memory");
        } else {
            XB_SPIN(xb_ld(&bar[XB_XGEN(b.x)]) == gen, bar);
            __builtin_amdgcn_fence(__ATOMIC_ACQUIRE, "agent");
            asm volatile("s_waitcnt vmcnt(0)" ::: "memory");
        }
    }
    __syncthreads();
}

constexpr int NPHASE = 10;
__global__ void __launch_bounds__(NTHREADS, 2) fwd(Args args) {
    extern __shared__ __attribute__((aligned(16))) unsigned char lds_raw[];
    LAS unsigned char* lds = (LAS unsigned char*)lds_raw;
    const int lo = args.ph_lo, hi = args.ph_hi;
    unsigned char* ws = args.ws;
    volatile LAS unsigned* bst = (volatile LAS unsigned*)(lds + LDS_BYTES - 32);
    if (threadIdx.x < 2) bst[threadIdx.x] = 0u;
    __syncthreads();
    XcdBarrier bar; bar.bar = (unsigned*)(ws + WS_CTL) + CW_BAR; bar.x = 0; bar.st = bst;
    if (hi - lo > 1) bar = xcd_barrier_post((unsigned*)(ws + WS_CTL) + CW_BAR, bst);
#define SEAM(k) do { if (IN(k) && IN((k) + 1)) { xcd_barrier(bar); } } while (0)
#ifndef PHMASK
#define PHMASK 0x3ff
#endif
#define IN(k) ((PHMASK >> (k) & 1) && lo <= (k) && (k) < hi)
    if (IN(0)) { phase0(args, lds); } SEAM(0);
    if (IN(1)) { phase1(args, lds); } SEAM(1);
    if (IN(2)) {
        pg8::Gemm g{(const bf16_t*)args.out, (const bf16_t*)(ws + WS_WEXT), TOK, NPROJ, DM}; pg8::StaticOrder S; S.init(TOK, NPROJ, gridDim.x, blockIdx.x);
        pg8::EpiProj E{(bf16_t*)(ws + WS_PROJ), (bf16_t*)(ws + WS_PROJR), C2};
        pg8::gemm_phase<pg8::EpiProj, pg8::StaticOrder, true, true>(lds, g, S, E);
    } SEAM(2);
    if (IN(3)) { phase3(args, lds); } SEAM(3);
    if (IN(4)) { phase4(args, lds); } SEAM(4);
    if (IN(5)) {
        pg8::Gemm g{(const bf16_t*)((unsigned char*)args.out + 64 * MiB), (const bf16_t*)(ws + WS_WOUT), TOK, DM, DM}; pg8::StaticOrder S; S.init(TOK, DM, gridDim.x, blockIdx.x);
        pg8::EpiBf16Ssq E{(bf16_t*)(ws + WS_YMIX), DM, (float*)(ws + WS_SSQ1)};
        pg8::gemm_phase<pg8::EpiBf16Ssq, pg8::StaticOrder, true, true>(lds, g, S, E);
    } SEAM(5);
    if (IN(6)) { phase6(args, lds); } SEAM(6);
    if (IN(7)) {
        pg8::Gemm g{(const bf16_t*)(ws + WS_H2), (const bf16_t*)(ws + WS_WGU), TOK, 2 * FFH, DM}; pg8::StaticOrder S; S.init(TOK, 2 * FFH, gridDim.x, blockIdx.x);
        pg8::EpiSwiGlu E{(bf16_t*)(ws + WS_HID), FFH};
        pg8::gemm_phase<pg8::EpiSwiGlu, pg8::StaticOrder, true, true>(lds, g, S, E);
    } SEAM(7);
    if (IN(8)) {
        pg8::Gemm g{(const bf16_t*)(ws + WS_HID), (const bf16_t*)(ws + WS_WDN), TOK, DM, FFH}; pg8::StaticOrder S; S.init(TOK, DM, gridDim.x, blockIdx.x);
        pg8::EpiBf16Ssq E{(bf16_t*)(ws + WS_F), DM, (float*)(ws + WS_SSQ2)};
        pg8::gemm_phase<pg8::EpiBf16Ssq, pg8::StaticOrder, true, true>(lds, g, S, E);
    } SEAM(8);
    if (IN(9)) { phase9(args, lds); }
#undef IN
#undef SEAM
}

extern "C" void kernel_launch(void* const* d_in, const int* in_sizes, int n_in, void* d_out, int out_size, void* d_ws, size_t ws_size, hipStream_t stream) {
    static int grid = 0;
    if (grid == 0) {
        if (n_in != 37 || out_size != TOK * DM || ws_size < WS_END) { fprintf(stderr, "kernel_launch: unexpected shapes (n_in %d out %d ws %zu)\n", n_in, out_size, ws_size); grid = -1; return; }
        int dev = 0, cus = 0, per_cu = 0;
        hipGetDevice(&dev); hipDeviceGetAttribute(&cus, hipDeviceAttributeMultiprocessorCount, dev);
        hipFuncSetAttribute((const void*)fwd, hipFuncAttributeMaxDynamicSharedMemorySize, LDS_BYTES);
        hipOccupancyMaxActiveBlocksPerMultiprocessor(&per_cu, (const void*)fwd, NTHREADS, LDS_BYTES);
        (void)hipGetLastError();
        if (per_cu < 1) { fprintf(stderr, "kernel_launch: occupancy query says %d blocks per CU\n", per_cu); per_cu = 1; }
        grid = cus;
        fprintf(stderr, "kernel_launch: cus %d per_cu %d grid %d ws %zu\n", cus, per_cu, grid, ws_size);
    }
    if (grid < 0) return;
    hipMemsetAsync((char*)d_ws + WS_CTL, 0, CTL_ZERO_BYTES, stream);
    Args a{};
    for (int i = 0; i < 37; ++i) a.in[i] = (const float*)d_in[i];
    a.out = (float*)d_out; a.ws = (unsigned char*)d_ws;
#if defined(PROBE_DOUBLE)
    for (int p = 0; p < NPHASE; ++p) { a.ph_lo = p; a.ph_hi = p + 1; a.flags = 0; hipLaunchKernelGGL(fwd, dim3(grid), dim3(NTHREADS), LDS_BYTES, stream, a);
        if ((PROBE_DOUBLE >> p) & 1) { if (p == 4) { hipMemsetAsync((char*)d_ws + WS_CTL, 0, CTL_ZERO_BYTES, stream); a.flags = PROBE_P4FLAGS; }
            hipLaunchKernelGGL(fwd, dim3(grid), dim3(NTHREADS), LDS_BYTES, stream, a); } }
#elif N_LAUNCH_MODE == 1
    a.ph_lo = 0; a.ph_hi = NPHASE;
    void* kargs[] = {&a};
    hipError_t e = hipLaunchCooperativeKernel((const void*)fwd, dim3(grid), dim3(NTHREADS), kargs, LDS_BYTES, stream);
    if (e != hipSuccess) fprintf(stderr, "cooperative launch failed: %s (grid %d)\n", hipGetErrorString(e), grid);
#else
    for (int p = 0; p < NPHASE; ++p) { a.ph_lo = p; a.ph_hi = p + 1; hipLaunchKernelGGL(fwd, dim3(grid), dim3(NTHREADS), LDS_BYTES, stream, a); }
#endif
}
```
